# Optimizing an MI355X kernel written in HIP

```python
import math
import jax, jax.numpy as jnp
from jax import lax
import numpy as np

D_MODEL = 1024
BATCH = 4
SEQ = 8192
DEPTH = 4

HEAD_DIM = 64
BLOCK = 128
SWA_Q_HEADS = 8
SWA_KV_HEADS = 2
SWA_WINDOW = 128
DIFF_HEADS = 4
DIFF_V_DIM = 2 * HEAD_DIM
BRANCH_WIDTH = SWA_Q_HEADS * HEAD_DIM
N_BRANCHES = 2
N_ALIBI_HEADS = SWA_Q_HEADS + DIFF_HEADS
FFN_HIDDEN = -(-8 * D_MODEL // (3 * 256)) * 256
COL_SWA_Q = SWA_Q_HEADS * HEAD_DIM
COL_SWA_K = SWA_KV_HEADS * HEAD_DIM
COL_SWA_V = SWA_KV_HEADS * HEAD_DIM
COL_DIFF_Q = DIFF_HEADS * 2 * HEAD_DIM
COL_DIFF_K = DIFF_HEADS * 2 * HEAD_DIM
COL_DIFF_V = DIFF_HEADS * DIFF_V_DIM
COL_GATE = N_BRANCHES * D_MODEL
IN_COLS = COL_SWA_Q + COL_SWA_K + COL_SWA_V + COL_DIFF_Q + COL_DIFF_K + COL_DIFF_V + COL_GATE
NEG = -1e30
EPS = 1e-6

kernel_name = "hybrid_swa_sink_diffattn_gated"


def rms_norm(x, gain):
    xf = x.astype(jnp.float32)
    y = xf * lax.rsqrt(jnp.mean(xf * xf, axis=-1, keepdims=True) + EPS)
    return (y * gain.astype(jnp.float32)).astype(x.dtype)


def alibi_slopes():
    return jnp.exp2(-8.0 * jnp.arange(1, N_ALIBI_HEADS + 1, dtype=jnp.float32) / N_ALIBI_HEADS)


def swa_attention(q, k, v, sinks, slopes):
    bsz, seq = q.shape[0], q.shape[1]
    nb = seq // BLOCK
    grp = SWA_Q_HEADS // SWA_KV_HEADS
    qb = q.reshape(bsz, nb, BLOCK, SWA_KV_HEADS, grp, HEAD_DIM)
    kb = k.reshape(bsz, nb, BLOCK, SWA_KV_HEADS, HEAD_DIM)
    vb = v.reshape(bsz, nb, BLOCK, SWA_KV_HEADS, HEAD_DIM)
    pad = ((0, 0), (1, 0), (0, 0), (0, 0), (0, 0))
    kcat = jnp.concatenate([jnp.pad(kb, pad)[:, :-1], kb], axis=2)
    vcat = jnp.concatenate([jnp.pad(vb, pad)[:, :-1], vb], axis=2)
    s = jnp.einsum("bnqhgd,bnkhd->bnhgqk", qb, kcat).astype(jnp.float32) * (HEAD_DIM ** -0.5)
    dist = (BLOCK + jnp.arange(BLOCK))[:, None] - jnp.arange(2 * BLOCK)[None, :]
    in_window = (dist >= 0) & (dist < SWA_WINDOW)
    has_prev = (jnp.arange(nb)[:, None] > 0) | (jnp.arange(2 * BLOCK)[None, :] >= BLOCK)
    mask = in_window[None] & has_prev[:, None, :]
    bias = -slopes.reshape(SWA_KV_HEADS, grp)[:, :, None, None] * dist.astype(jnp.float32)
    s = jnp.where(mask[None, :, None, None], s + bias, NEG)
    sink = jnp.broadcast_to(sinks.astype(jnp.float32).reshape(SWA_KV_HEADS, grp)[None, None, :, :, None, None],
                            s.shape[:-1] + (1,))
    p = jax.nn.softmax(jnp.concatenate([s, sink], axis=-1), axis=-1)[..., :-1]
    o = jnp.einsum("bnhgqk,bnkhd->bnqhgd", p.astype(v.dtype), vcat)
    return o.reshape(bsz, seq, SWA_Q_HEADS * HEAD_DIM)


def diff_attention(q, k, v, lam, slopes):
    bsz, seq = q.shape[0], q.shape[1]
    nb = seq // BLOCK
    qb = q.reshape(bsz, nb, BLOCK, DIFF_HEADS, 2, HEAD_DIM).transpose(1, 0, 2, 3, 4, 5)
    kpos = jnp.arange(seq)

    def one_block(args):
        q_blk, n = args
        s = jnp.einsum("bqhcd,bkhcd->bhcqk", q_blk, k).astype(jnp.float32) * (HEAD_DIM ** -0.5)
        dist = (n * BLOCK + jnp.arange(BLOCK))[:, None] - kpos[None, :]
        s = s - slopes[None, :, None, None, None] * dist.astype(jnp.float32)
        s = jnp.where(dist >= 0, s, NEG)
        p = jax.nn.softmax(s, axis=-1)
        w = p[:, :, 0] - lam * p[:, :, 1]
        return jnp.einsum("bhqk,bkhe->bqhe", w.astype(v.dtype), v)

    out = lax.map(one_block, (qb, jnp.arange(nb)))
    return out.transpose(1, 0, 2, 3, 4).reshape(bsz, seq, DIFF_HEADS, DIFF_V_DIM)


def setup_inputs(seed: int = 0) -> dict:
    key = jax.random.key(seed)
    ks = jax.random.split(key, 14)
    f32 = jnp.float32
    nrm = lambda k, shape, scale: jax.random.normal(k, shape, f32) * scale
    return {
        "x": jax.random.normal(ks[0], (BATCH, SEQ, D_MODEL), f32),
        "w_in": nrm(ks[1], (DEPTH, D_MODEL, IN_COLS), D_MODEL ** -0.5),
        "b_gate": nrm(ks[2], (DEPTH, N_BRANCHES, D_MODEL), 0.1),
        "w_branch": nrm(ks[3], (DEPTH, N_BRANCHES, BRANCH_WIDTH, D_MODEL), BRANCH_WIDTH ** -0.5),
        "w_o": nrm(ks[4], (DEPTH, D_MODEL, D_MODEL), D_MODEL ** -0.5),
        "norm_mix": 1.0 + nrm(ks[5], (DEPTH, D_MODEL), 0.02),
        "norm_ffn": 1.0 + nrm(ks[6], (DEPTH, D_MODEL), 0.02),
        "qk_norm_swa": 1.0 + nrm(ks[7], (DEPTH, 2, HEAD_DIM), 0.02),
        "qk_norm_diff": 1.0 + nrm(ks[8], (DEPTH, 2, HEAD_DIM), 0.02),
        "attn_sinks": nrm(ks[9], (DEPTH, SWA_Q_HEADS), 0.5),
        "diff_lambda": nrm(ks[10], (DEPTH, 4, HEAD_DIM), 0.1),
        "diff_subln": 1.0 + nrm(ks[11], (DEPTH, DIFF_V_DIM), 0.02),
        "w_ffn_in": nrm(ks[12], (DEPTH, D_MODEL, 2 * FFN_HIDDEN), D_MODEL ** -0.5),
        "w_ffn_out": nrm(ks[13], (DEPTH, FFN_HIDDEN, D_MODEL), FFN_HIDDEN ** -0.5),
    }


def reference(x, w_in, b_gate, w_branch, w_o, norm_mix, norm_ffn, qk_norm_swa, qk_norm_diff,
              attn_sinks, diff_lambda, diff_subln, w_ffn_in, w_ffn_out):
    bsz, seq = x.shape[0], x.shape[1]
    slopes = alibi_slopes()
    slopes_swa, slopes_diff = slopes[:SWA_Q_HEADS], slopes[SWA_Q_HEADS:]
    splits = list(np.cumsum([COL_SWA_Q, COL_SWA_K, COL_SWA_V, COL_DIFF_Q, COL_DIFF_K, COL_DIFF_V]))
    for l in range(DEPTH):
        h = rms_norm(x, norm_mix[l])
        proj = h @ w_in[l]
        qa, ka, va, qd, kd, vd, gate_logits = jnp.split(proj, splits, axis=-1)
        qa = rms_norm(qa.reshape(bsz, seq, SWA_Q_HEADS, HEAD_DIM), qk_norm_swa[l, 0])
        ka = rms_norm(ka.reshape(bsz, seq, SWA_KV_HEADS, HEAD_DIM), qk_norm_swa[l, 1])
        va = va.reshape(bsz, seq, SWA_KV_HEADS, HEAD_DIM)
        o_a = swa_attention(qa, ka, va, attn_sinks[l], slopes_swa)
        qd = rms_norm(qd.reshape(bsz, seq, DIFF_HEADS, 2, HEAD_DIM), qk_norm_diff[l, 0])
        kd = rms_norm(kd.reshape(bsz, seq, DIFF_HEADS, 2, HEAD_DIM), qk_norm_diff[l, 1])
        vd = vd.reshape(bsz, seq, DIFF_HEADS, DIFF_V_DIM)
        lam_init = 0.8 - 0.6 * math.exp(-0.3 * l)
        lp = diff_lambda[l].astype(jnp.float32)
        lam = jnp.exp(jnp.sum(lp[0] * lp[1])) - jnp.exp(jnp.sum(lp[2] * lp[3])) + lam_init
        o_d = diff_attention(qd, kd, vd, lam, slopes_diff)
        o_b = (rms_norm(o_d, diff_subln[l]) * (1.0 - lam_init)).reshape(bsz, seq, BRANCH_WIDTH)
        gates = jax.nn.sigmoid(gate_logits.reshape(bsz, seq, N_BRANCHES, D_MODEL) + b_gate[l])
        branches = jnp.stack([o_a, o_b], axis=2)
        up = jnp.einsum("bsnc,ncd->bsnd", branches, w_branch[l])
        merged = jnp.einsum("bsnd,bsnd->bsd", gates, up)
        x = x + merged @ w_o[l]
        h2 = rms_norm(x, norm_ffn[l])
        g, u = jnp.split(h2 @ w_ffn_in[l], 2, axis=-1)
        x = x + (jax.nn.silu(g) * u) @ w_ffn_out[l]
    return x
```

```cpp
#include <hip/hip_runtime.h>
#include <hip/hip_cooperative_groups.h>
#include <cstdio>
#include <cstdint>
namespace cg = cooperative_groups;
namespace pg8 {
#define PG8_LAS __attribute__((address_space(3)))
typedef unsigned short bf16_t;
typedef short bf16x8 __attribute__((ext_vector_type(8)));
typedef float f32x4 __attribute__((ext_vector_type(4)));
typedef unsigned u32x4 __attribute__((ext_vector_type(4)));
constexpr int BM = 256, BK = 64, HALF = 128, HTB = HALF * BK * 2  , STAGE_BYTES = 8 * HTB, NXCD = 8, WGM = 4;

__host__ __device__ __forceinline__ int lds_byte(int r, int c) { const int st = (r >> 4) * 2 + (c >> 5), rr = r & 15, cc = c & 31, ob = rr * 64 + cc * 2; return st * 1024 + (ob ^ (((ob >> 9) & 1) << 5)); }
__host__ __device__ __forceinline__ void stage_rc(int b, int& R, int& C) { const int st = b / 1024, sb = b % 1024, swz = sb ^ (((sb >> 9) & 1) << 5); R = (st >> 1) * 16 + swz / 64; C = (st & 1) * 32 + (swz % 64) / 2; }
__host__ __device__ __forceinline__ int perm32(int rho) { const int n = rho >> 4, i = rho & 15; return 8 * (i >> 2) + 4 * n + (i & 3); }

struct Unit { int pm, pn, z; };
struct Gemm { const bf16_t* A; const bf16_t* Bt; int M, N, K; size_t zA, zB; };

struct StaticOrder {
    int nM, nN, nwg, G, c;
    __host__ __device__ void init(int M, int N, int G_, int c_) { nM = M / BM; nN = N / BM; nwg = nM * nN; G = G_; c = c_; }
    __host__ __device__ bool next(int i, Unit& u) const {
        const long L = (long)i * G + c; if (L >= nwg) return false;
        int wgid = (int)L; { const int q = nwg / NXCD, r = nwg % NXCD, xcd = wgid % NXCD, off = wgid / NXCD; wgid = (xcd < r ? xcd * (q + 1) : r * (q + 1) + (xcd - r) * q) + off; }
        const int nig = WGM * nN, gid = wgid / nig, fm = gid * WGM, gsz = (nM - fm) < WGM ? (nM - fm) : WGM;
        u.pm = fm + ((wgid % nig) % gsz); u.pn = (wgid % nig) / gsz; u.z = 0; return true;
    }
    __device__ __forceinline__ void a_ready(const Unit&) const {}
    __device__ __forceinline__ void done(const Unit&) const {}
};

typedef float f32x2_t __attribute__((ext_vector_type(2))); typedef __bf16 bf16x2_t __attribute__((ext_vector_type(2)));
__device__ __forceinline__ unsigned cvt_pk_bf16(float lo, float hi) { f32x2_t v = {lo, hi}; bf16x2_t b = __builtin_convertvector(v, bf16x2_t); return __builtin_bit_cast(unsigned, b); }
__device__ __forceinline__ u32x4 pack8(const f32x4 a, const f32x4 b) { u32x4 w; w.x = cvt_pk_bf16(a[0], a[1]); w.y = cvt_pk_bf16(a[2], a[3]); w.z = cvt_pk_bf16(b[0], b[1]); w.w = cvt_pk_bf16(b[2], b[3]); return w; }
__device__ __forceinline__ float bflo(unsigned w) { return __uint_as_float(w << 16); }
__device__ __forceinline__ float bfhi(unsigned w) { return __uint_as_float(w & 0xffff0000u); }
constexpr float RMS_EPS = 1e-6f;
constexpr float QC2 = 0.125f * 1.4426950408889634f;
constexpr int PSS_M = 32768;
__device__ __forceinline__ float row_rstd(const float* pss, int r, int fq) {
    float s = pss[(size_t)fq * PSS_M + r];
    s += __shfl_xor(s, 16); s += __shfl_xor(s, 32);
    return __builtin_amdgcn_rsqf(s * (1.0f / 1024.0f) + RMS_EPS);
}
struct EpiInProj {
    static constexpr bool PERM = true, AFTER_DRAIN = false;
    bf16_t* qkv; bf16_t* gate; const float* pss; const float* qkn_swa; const float* qkn_diff; const float* bgate;
    __device__ __forceinline__ bool keep(const Unit&) const { return false; }
    __device__ __forceinline__ void operator()(f32x4 (&acc)[2][2][4][2], const Unit& u, int wr, int wc, int fr, int fq) const {
        const int row0 = u.pm * BM + wr * 64 + fr;
        float rs[2][4];
#pragma unroll
        for (int ai = 0; ai < 2; ++ai)
#pragma unroll
            for (int m = 0; m < 4; ++m) rs[ai][m] = row_rstd(pss, row0 + ai * HALF + m * 16, fq);
        if (u.pn < 9) {
            const int lc0 = u.pn * 256 + wc * 64;
            const float* gp = nullptr; float sc = 1.f;
            if (lc0 < 512) { gp = qkn_swa; sc = QC2; } else if (lc0 < 640) { gp = qkn_swa + 64; } else if (lc0 < 768) { } else if (lc0 < 1280) { gp = qkn_diff; sc = QC2; } else if (lc0 < 1792) { gp = qkn_diff + 64; }
            f32x4 gv[2][2];
#pragma unroll
            for (int bj = 0; bj < 2; ++bj)
#pragma unroll
                for (int n = 0; n < 2; ++n) gv[bj][n] = gp ? *(const f32x4*)(gp + 32 * bj + 8 * fq + 4 * n) * sc : (f32x4){1.f, 1.f, 1.f, 1.f};
#pragma unroll
            for (int ai = 0; ai < 2; ++ai)
#pragma unroll
                for (int m = 0; m < 4; ++m) {
                    const int r = row0 + ai * HALF + m * 16; const float rstd = rs[ai][m];
                    float sc_row = rstd;
                    if (gp) { float ss = 0.f;
#pragma unroll
                        for (int bj = 0; bj < 2; ++bj)
#pragma unroll
                            for (int n = 0; n < 2; ++n) { const f32x4 q = acc[ai][bj][m][n] * acc[ai][bj][m][n]; ss += (q[0] + q[1]) + (q[2] + q[3]); }
                        ss += __shfl_xor(ss, 16); ss += __shfl_xor(ss, 32);
                        sc_row = rstd * __builtin_amdgcn_rsqf(ss * (rstd * rstd) * (1.0f / 64.0f) + RMS_EPS); }
                    bf16_t* rowp = qkv + (size_t)r * 2304 + lc0 + 8 * fq;
#pragma unroll
                    for (int bj = 0; bj < 2; ++bj) *(u32x4*)(rowp + 32 * bj) = pack8(acc[ai][bj][m][0] * sc_row * gv[bj][0], acc[ai][bj][m][1] * sc_row * gv[bj][1]);
                }
        } else {
            const int g0 = (u.pn - 9) * 256 + wc * 32 + 8 * fq;
            f32x4 bv[2][2];
#pragma unroll
            for (int bj = 0; bj < 2; ++bj)
#pragma unroll
                for (int n = 0; n < 2; ++n) bv[bj][n] = *(const f32x4*)(bgate + g0 + bj * HALF + 4 * n);
#pragma unroll
            for (int ai = 0; ai < 2; ++ai)
#pragma unroll
                for (int m = 0; m < 4; ++m) {
                    const int r = row0 + ai * HALF + m * 16; const float rstd = rs[ai][m];
                    bf16_t* rowp = gate + (size_t)r * 2048 + g0;
#pragma unroll
                    for (int bj = 0; bj < 2; ++bj) { f32x4 s[2];
#pragma unroll
                        for (int n = 0; n < 2; ++n) { const f32x4 v = acc[ai][bj][m][n] * rstd + bv[bj][n];
#pragma unroll
                            for (int i = 0; i < 4; ++i) s[n][i] = __builtin_amdgcn_rcpf(1.0f + __builtin_amdgcn_exp2f(v[i] * -1.4426950408889634f)); }
                        *(u32x4*)(rowp + bj * HALF) = pack8(s[0], s[1]); }
                }
        }
    }
};
struct EpiGateMerge {
    static constexpr bool PERM = true, AFTER_DRAIN = false;
    const bf16_t* gate; bf16_t* merged;
    __device__ __forceinline__ bool keep(const Unit& u) const { return u.z == 0; }
    __device__ __forceinline__ void operator()(f32x4 (&acc)[2][2][4][2], const Unit& u, int wr, int wc, int fr, int fq) const {
        const int row0 = u.pm * BM + wr * 64 + fr, col0 = u.pn * BM + wc * 32 + 8 * fq;
#pragma unroll
        for (int ai = 0; ai < 2; ++ai)
#pragma unroll
        for (int mh = 0; mh < 2; ++mh) {
            u32x4 g1v[2][2];
#pragma unroll
            for (int mm = 0; mm < 2; ++mm)
#pragma unroll
                for (int bj = 0; bj < 2; ++bj) g1v[mm][bj] = *(const u32x4*)(gate + (size_t)(row0 + ai * HALF + (2 * mh + mm) * 16) * 2048 + 1024 + col0 + bj * HALF);
#pragma unroll
            for (int mm = 0; mm < 2; ++mm)
#pragma unroll
                for (int bj = 0; bj < 2; ++bj) { const int m = 2 * mh + mm; const int r = row0 + ai * HALF + m * 16; const u32x4 g1 = g1v[mm][bj];
                    const f32x4 g1a = {bflo(g1.x), bfhi(g1.x), bflo(g1.y), bfhi(g1.y)}, g1b = {bflo(g1.z), bfhi(g1.z), bflo(g1.w), bfhi(g1.w)};
                    if (u.z == 0) {
                        const u32x4 g0 = *(const u32x4*)(gate + (size_t)r * 2048 + col0 + bj * HALF);
                        const f32x4 g0a = {bflo(g0.x), bfhi(g0.x), bflo(g0.y), bfhi(g0.y)}, g0b = {bflo(g0.z), bfhi(g0.z), bflo(g0.w), bfhi(g0.w)};
#pragma unroll
                        for (int i = 0; i < 4; ++i) { acc[ai][bj][m][0][i] *= g0a[i] * __builtin_amdgcn_rcpf(__builtin_fmaxf(g1a[i], 1e-30f)); acc[ai][bj][m][1][i] *= g0b[i] * __builtin_amdgcn_rcpf(__builtin_fmaxf(g1b[i], 1e-30f)); }
                    } else {
                        *(u32x4*)(merged + (size_t)r * 1024 + col0 + bj * HALF) = pack8(acc[ai][bj][m][0] * g1a, acc[ai][bj][m][1] * g1b); }
                }
        }
    }
};
struct EpiResid {
    static constexpr bool PERM = true, AFTER_DRAIN = false;
    float* xout; bf16_t* xb; float* pss; PG8_LAS float* red;
    __device__ __forceinline__ bool keep(const Unit&) const { return false; }
    __device__ __forceinline__ void operator()(f32x4 (&acc)[2][2][4][2], const Unit& u, int wr, int wc, int fr, int fq) const {
        const int row0 = u.pm * BM + wr * 64 + fr, col0 = u.pn * BM + wc * 32 + 8 * fq;
#pragma unroll
        for (int ai = 0; ai < 2; ++ai) {
            u32x4 xov[4][2];
#pragma unroll
            for (int m = 0; m < 4; ++m)
#pragma unroll
                for (int bj = 0; bj < 2; ++bj) xov[m][bj] = *(const u32x4*)(xb + (size_t)(row0 + ai * HALF + m * 16) * 1024 + col0 + bj * HALF);
#pragma unroll
            for (int m = 0; m < 4; ++m) {
                const int r = row0 + ai * HALF + m * 16; const size_t off = (size_t)r * 1024 + col0; float ss = 0.f;
#pragma unroll
                for (int bj = 0; bj < 2; ++bj) {
                    const u32x4 xo = xov[m][bj];
                    f32x4 xn[2]; xn[0] = (f32x4){bflo(xo.x), bfhi(xo.x), bflo(xo.y), bfhi(xo.y)} + acc[ai][bj][m][0]; xn[1] = (f32x4){bflo(xo.z), bfhi(xo.z), bflo(xo.w), bfhi(xo.w)} + acc[ai][bj][m][1];
#pragma unroll
                    for (int n = 0; n < 2; ++n) { const f32x4 q = xn[n] * xn[n]; ss += (q[0] + q[1]) + (q[2] + q[3]); if (xout) *(f32x4*)(xout + off + bj * HALF + 4 * n) = xn[n]; }
                    *(u32x4*)(xb + off + bj * HALF) = pack8(xn[0], xn[1]); }
                ss += __shfl_xor(ss, 16); ss += __shfl_xor(ss, 32);
                if (fq == 0) red[(ai * HALF + wr * 64 + m * 16 + fr) * 4 + wc] = ss;
            }
        }
        asm volatile("s_waitcnt lgkmcnt(0)" ::: "memory"); __builtin_amdgcn_s_barrier(); asm volatile("" ::: "memory");
        { const int t = (wr * 4 + wc) * 64 + fq * 16 + fr;
          if (t < BM) { const f32x4 p = *(const PG8_LAS f32x4*)(red + t * 4); pss[(size_t)u.pn * PSS_M + u.pm * BM + t] = (p[0] + p[1]) + (p[2] + p[3]); } }
    }
};
struct EpiSwiGLU {
    static constexpr bool PERM = true, AFTER_DRAIN = false;
    bf16_t* act; const float* pss;
    __device__ __forceinline__ bool keep(const Unit&) const { return false; }
    __device__ __forceinline__ void operator()(f32x4 (&acc)[2][2][4][2], const Unit& u, int wr, int wc, int fr, int fq) const {
        const int row0 = u.pm * BM + wr * 64 + fr, col0 = u.pn * 128 + wc * 32 + 8 * fq;
        float rs[2][4];
#pragma unroll
        for (int ai = 0; ai < 2; ++ai)
#pragma unroll
            for (int m = 0; m < 4; ++m) rs[ai][m] = row_rstd(pss, row0 + ai * HALF + m * 16, fq);
#pragma unroll
        for (int ai = 0; ai < 2; ++ai)
#pragma unroll
            for (int m = 0; m < 4; ++m) {
                const int r = row0 + ai * HALF + m * 16; const float rstd = rs[ai][m]; f32x4 a[2];
#pragma unroll
                for (int n = 0; n < 2; ++n) { const f32x4 g = acc[ai][0][m][n] * rstd, uu = acc[ai][1][m][n] * rstd;
#pragma unroll
                    for (int i = 0; i < 4; ++i) a[n][i] = g[i] * __builtin_amdgcn_rcpf(1.0f + __builtin_amdgcn_exp2f(g[i] * -1.4426950408889634f)) * uu[i]; }
                *(u32x4*)(act + (size_t)r * 2816 + col0) = pack8(a[0], a[1]);
            }
    }
};
struct ZOrder {
    StaticOrder S;
    __device__ __forceinline__ bool next(int i, Unit& u) const { if (!S.next(i >> 1, u)) return false; u.z = i & 1; return true; }
    __device__ __forceinline__ void a_ready(const Unit&) const {}
    __device__ __forceinline__ void done(const Unit&) const {}
};

template <class Epi, class Sched, bool ALIGN_EPI = false, bool SP2 = false>
__device__ __forceinline__ void gemm_phase(PG8_LAS unsigned char* lds, const Gemm g, const Sched& S, const Epi& E) {
    int tid = threadIdx.x; asm volatile("" : "+v"(tid));
    const int wid = __builtin_amdgcn_readfirstlane(tid >> 6), lane = tid & 63, wr = wid >> 2, wc = wid & 3, fr = lane & 15, fq = lane >> 4;
    const int K = g.K, nt = K / BK;
    unsigned voffA[2], voffB[2];
#pragma unroll
    for (int i = 0; i < 2; ++i) { int R, C; stage_rc(tid * 16 + i * 8192, R, C); const int Rb = Epi::PERM ? ((R & ~31) + perm32(R & 31)) : R;
        voffA[i] = (unsigned)(R * K + C) * 2u; voffB[i] = (unsigned)(Rb * K + C) * 2u; }
    const size_t kstep = (size_t)(BK * 2);
    const size_t hstep = (size_t)HALF * K * 2;
    const size_t tstep = 2 * hstep;
    const unsigned ldsw = (unsigned)wid * 1024u;
    const int aoff = lds_byte(wr * 64 + fr, fq * 8), boff = lds_byte(wc * 32 + fr, fq * 8);
#define PG8_SA(b, h) (((b) * 2 + (h)) * HTB)
#define PG8_SB(b, h) ((4 + (b) * 2 + (h)) * HTB)
#define PG8_STAGE(bufoff, gbase, voff) do { _Pragma("unroll") for (int _i = 0; _i < 2; ++_i) \
        __builtin_amdgcn_global_load_lds((const unsigned*)((const char*)(gbase) + (voff)[_i]), (PG8_LAS unsigned*)(lds + (bufoff) + ldsw + _i * 8192), 16, 0, 0); } while (0)
#define PG8_LDA(dst, b, h) do { _Pragma("unroll") for (int m = 0; m < 4; ++m) _Pragma("unroll") for (int k = 0; k < 2; ++k) dst[m][k] = *(const PG8_LAS bf16x8*)(lds + PG8_SA(b, h) + aoff + m * 2048 + k * 1024); } while (0)
#define PG8_LDB(dst, b, h) do { _Pragma("unroll") for (int n = 0; n < 2; ++n) _Pragma("unroll") for (int k = 0; k < 2; ++k) dst[n][k] = *(const PG8_LAS bf16x8*)(lds + PG8_SB(b, h) + boff + n * 2048 + k * 1024); } while (0)
#define PG8_MMA(ai, bj, At, Bt) do { __builtin_amdgcn_s_setprio(1); _Pragma("unroll") for (int m = 0; m < 4; ++m) _Pragma("unroll") for (int n = 0; n < 2; ++n) _Pragma("unroll") for (int k = 0; k < 2; ++k) \
        acc[ai][bj][m][n] = __builtin_amdgcn_mfma_f32_16x16x32_bf16(Bt[n][k], At[m][k], acc[ai][bj][m][n], 0, 0, 0); __builtin_amdgcn_s_setprio(0); } while (0)
#define PG8_WAIT_V(n) asm volatile("s_waitcnt vmcnt(" #n ")" ::: "memory")
#define PG8_WAIT_L(n) asm volatile("s_waitcnt lgkmcnt(" #n ")" ::: "memory")
#define PG8_BAR __builtin_amdgcn_s_barrier()
#define PG8_SCHED __builtin_amdgcn_sched_barrier(0)
    Unit cur, nxt; int ui = 0;
    if (!S.next(0, cur)) return;
    f32x4 acc[2][2][4][2];
#pragma unroll
    for (int a = 0; a < 2; ++a)
#pragma unroll
        for (int b = 0; b < 2; ++b)
#pragma unroll
            for (int m = 0; m < 4; ++m)
#pragma unroll
                for (int n = 0; n < 2; ++n) acc[a][b][m][n] = (f32x4){0.f, 0.f, 0.f, 0.f};
    bf16x8 At[4][2], B0[2][2], B1[2][2];
    const char* cA = (const char*)g.A + (size_t)cur.pm * tstep + (size_t)cur.z * g.zA; const char* cB = (const char*)g.Bt + (size_t)cur.pn * tstep + (size_t)cur.z * g.zB;
    S.a_ready(cur);
    if constexpr (SP2) {
        PG8_STAGE(PG8_SB(0, 0), cB, voffB); PG8_STAGE(PG8_SB(0, 1), cB + hstep, voffB); PG8_STAGE(PG8_SA(0, 0), cA, voffA); PG8_STAGE(PG8_SA(0, 1), cA + hstep, voffA);
        if (wr == 1) PG8_BAR;
        PG8_WAIT_V(2); PG8_BAR;
        PG8_STAGE(PG8_SB(1, 0), cB + kstep, voffB); PG8_STAGE(PG8_SA(1, 0), cA + kstep, voffA); PG8_STAGE(PG8_SB(1, 1), cB + hstep + kstep, voffB);
        PG8_WAIT_V(6); PG8_BAR;
    } else {
        PG8_STAGE(PG8_SB(0, 0), cB, voffB); PG8_STAGE(PG8_SA(0, 0), cA, voffA); PG8_STAGE(PG8_SB(0, 1), cB + hstep, voffB); PG8_STAGE(PG8_SA(0, 1), cA + hstep, voffA);
        if (wr == 1) PG8_BAR;
        PG8_WAIT_V(4); PG8_BAR;
        PG8_STAGE(PG8_SB(1, 0), cB + kstep, voffB); PG8_STAGE(PG8_SA(1, 0), cA + kstep, voffA); PG8_STAGE(PG8_SB(1, 1), cB + hstep + kstep, voffB);
        PG8_WAIT_V(6); PG8_BAR;
    }
    for (;;) {
        const bool has_next = S.next(ui + 1, nxt);
        const char* nA = has_next ? (const char*)g.A + (size_t)nxt.pm * tstep + (size_t)nxt.z * g.zA : cA; const char* nB = has_next ? (const char*)g.Bt + (size_t)nxt.pn * tstep + (size_t)nxt.z * g.zB : cB;
        for (int t = 0; t < nt; t += 2) {
            const bool last = (t == nt - 2);
            const char* a1 = cA + (size_t)(t + 1) * kstep;
            const char* a2 = last ? nA : cA + (size_t)(t + 2) * kstep; const char* b2 = last ? nB : cB + (size_t)(t + 2) * kstep;
            const char* a3 = a2 + kstep; const char* b3 = b2 + kstep;
            if (last && has_next) S.a_ready(nxt);
            if constexpr (SP2) {
            PG8_LDB(B0, 0, 0); PG8_LDB(B1, 0, 1); PG8_SCHED; PG8_LDA(At, 0, 0); PG8_STAGE(PG8_SA(1, 1), a1 + hstep, voffA);
            PG8_WAIT_V(8); PG8_WAIT_L(0); PG8_BAR; PG8_MMA(0, 0, At, B0); PG8_MMA(0, 1, At, B1); PG8_BAR; PG8_SCHED;
            PG8_LDA(At, 0, 1); PG8_STAGE(PG8_SB(0, 0), b2, voffB); PG8_STAGE(PG8_SB(0, 1), b2 + hstep, voffB); PG8_STAGE(PG8_SA(0, 0), a2, voffA);
            PG8_WAIT_V(8); PG8_WAIT_L(0); PG8_BAR; PG8_MMA(1, 0, At, B0); PG8_MMA(1, 1, At, B1); PG8_BAR; PG8_SCHED;
            PG8_LDB(B0, 1, 0); PG8_LDB(B1, 1, 1); PG8_SCHED; PG8_LDA(At, 1, 0); PG8_STAGE(PG8_SA(0, 1), a2 + hstep, voffA);
            PG8_WAIT_V(8); PG8_WAIT_L(0); PG8_BAR; PG8_MMA(0, 0, At, B0); PG8_MMA(0, 1, At, B1); PG8_BAR; PG8_SCHED;
            PG8_LDA(At, 1, 1); PG8_STAGE(PG8_SB(1, 0), b3, voffB); PG8_STAGE(PG8_SB(1, 1), b3 + hstep, voffB); PG8_STAGE(PG8_SA(1, 0), a3, voffA);
            PG8_WAIT_V(8); PG8_WAIT_L(0); PG8_BAR; PG8_MMA(1, 0, At, B0); PG8_MMA(1, 1, At, B1); PG8_BAR; PG8_SCHED;
            } else {
            PG8_LDB(B0, 0, 0); PG8_SCHED; PG8_LDA(At, 0, 0); PG8_STAGE(PG8_SA(1, 1), a1 + hstep, voffA);
            PG8_WAIT_L(8); PG8_BAR; PG8_WAIT_L(0); PG8_MMA(0, 0, At, B0); PG8_BAR; PG8_SCHED;
            PG8_LDB(B1, 0, 1); PG8_STAGE(PG8_SB(0, 0), b2, voffB);
            PG8_BAR; PG8_WAIT_L(0); PG8_MMA(0, 1, At, B1); PG8_BAR;
            PG8_LDA(At, 0, 1); PG8_STAGE(PG8_SA(0, 0), a2, voffA);
            PG8_BAR; PG8_WAIT_L(0); PG8_MMA(1, 0, At, B0); PG8_BAR; PG8_SCHED;
            PG8_STAGE(PG8_SB(0, 1), b2 + hstep, voffB);
            PG8_WAIT_V(6); PG8_BAR; PG8_MMA(1, 1, At, B1); PG8_BAR;
            PG8_LDB(B0, 1, 0); PG8_SCHED; PG8_LDA(At, 1, 0); PG8_STAGE(PG8_SA(0, 1), a2 + hstep, voffA);
            PG8_WAIT_L(8); PG8_BAR; PG8_WAIT_L(0); PG8_MMA(0, 0, At, B0); PG8_BAR; PG8_SCHED;
            PG8_LDB(B1, 1, 1); PG8_STAGE(PG8_SB(1, 0), b3, voffB);
            PG8_BAR; PG8_WAIT_L(0); PG8_MMA(0, 1, At, B1); PG8_BAR;
            PG8_LDA(At, 1, 1); PG8_STAGE(PG8_SA(1, 0), a3, voffA);
            PG8_BAR; PG8_WAIT_L(0); PG8_MMA(1, 0, At, B0); PG8_BAR; PG8_SCHED;
            PG8_STAGE(PG8_SB(1, 1), b3 + hstep, voffB);
            PG8_WAIT_V(6); PG8_BAR; PG8_MMA(1, 1, At, B1); PG8_BAR;
            }
        }
        if constexpr (ALIGN_EPI) { if (wr == 0) PG8_BAR; }
        if constexpr (!Epi::AFTER_DRAIN) { E(acc, cur, wr, wc, fr, fq); S.done(cur); }
        if (!has_next) break;
        if (!E.keep(cur)) {
#pragma unroll
        for (int a = 0; a < 2; ++a)
#pragma unroll
            for (int b = 0; b < 2; ++b)
#pragma unroll
                for (int m = 0; m < 4; ++m)
#pragma unroll
                    for (int n = 0; n < 2; ++n) acc[a][b][m][n] = (f32x4){0.f, 0.f, 0.f, 0.f};
        }
        cur = nxt; cA = nA; cB = nB; ++ui;
        if constexpr (ALIGN_EPI) { if (wr == 1) PG8_BAR; }
    }
    PG8_WAIT_V(0);
    if constexpr (!ALIGN_EPI) { if (wr == 0) PG8_BAR; }
    PG8_BAR;
    if constexpr (Epi::AFTER_DRAIN) { E.fused(acc, cur, wr, wc, fr, fq, lds, wid, lane); S.done(cur); }
#undef PG8_SA
#undef PG8_SB
#undef PG8_STAGE
#undef PG8_LDA
#undef PG8_LDB
#undef PG8_MMA
#undef PG8_WAIT_V
#undef PG8_WAIT_L
#undef PG8_BAR
#undef PG8_SCHED
}
}
#include <hip/hip_bf16.h>
#include <cmath>
namespace attn_body {
using bf16=__hip_bfloat16;
using bf16x8=__attribute__((ext_vector_type(8)))short;
using s16x4=__attribute__((ext_vector_type(4)))short;
using f32x16=__attribute__((ext_vector_type(16)))float;
using u32x4=__attribute__((ext_vector_type(4)))unsigned;
constexpr int SEQ=8192,D=64,PIN=2304,POUT=512;
constexpr int NW=8,QBLK=32,QB=QBLK*NW,KVBLK=64,NQB=SEQ/QB;
constexpr int ATTN_UNIT_ROWS=QB;
__device__ __forceinline__ int crow(int r,int hi){return (r&3)+8*(r>>2)+4*hi;}
#define SBAR() __builtin_amdgcn_sched_barrier(0)
__device__ __forceinline__ void gmask(f32x16&p0,f32x16&p1,int kvb,int qrel,int hi,bool WIN){
  const float NEG=-INFINITY; int kb=kvb+4*hi;
  #pragma unroll
  for(int r=0;r<16;++r){int kv=kb+(r&3)+8*(r>>2); if(kv>qrel)p0[r]=NEG; if(kv+32>qrel)p1[r]=NEG;
    if(WIN){ if(kv<=qrel-128)p0[r]=NEG; if(kv+32<=qrel-128)p1[r]=NEG; } }
}

constexpr int NSLOT=3, SLOTB=8192;
constexpr int LDS_K=0, LDS_V=NSLOT*SLOTB, LDS_WS=2*NSLOT*SLOTB, LDS_OST=LDS_WS+NW*64*4, LDS_BYTES=LDS_OST+NW*4096;
constexpr float C2=0.125f*1.4426950408889634f;
__device__ __forceinline__ void glds16(const void*gsrc,unsigned lds_dst){unsigned keep;
  asm volatile("s_mov_b32 %0, m0\n\ts_mov_b32 m0, %2\n\ts_nop 0\n\tglobal_load_lds_dwordx4 %1, off\n\ts_mov_b32 m0, %0":"=&s"(keep):"v"(gsrc),"s"(lds_dst):"memory");}
__device__ __forceinline__ float max3f(float a,float b,float c){float r;asm("v_max3_f32 %0, %1, %2, %3":"=v"(r):"v"(a),"v"(b),"v"(c));return r;}
__device__ __forceinline__ float max2f(float a,float b){float r;asm("v_max_f32_e32 %0, %1, %2":"=v"(r):"v"(a),"v"(b));return r;}
__device__ __forceinline__ float fadd_s(float a,float b){float r;asm("v_add_f32_e32 %0, %1, %2":"=v"(r):"v"(a),"v"(b));return r;}
__device__ __forceinline__ float fsub_s(float a,float b){float r;asm("v_sub_f32_e32 %0, %1, %2":"=v"(r):"v"(a),"v"(b));return r;}
typedef float f32x2_t __attribute__((ext_vector_type(2))); typedef __bf16 bf16x2_t __attribute__((ext_vector_type(2)));
__device__ __forceinline__ unsigned cvtpk_s(float lo,float hi){f32x2_t v={lo,hi};bf16x2_t b=__builtin_convertvector(v,bf16x2_t);return __builtin_bit_cast(unsigned,b);}
#define WAIT_BAR(N) asm volatile("s_waitcnt vmcnt(" #N ") lgkmcnt(0)\n\ts_barrier":::"memory")

__device__ __forceinline__ void qkt(f32x16&p0,f32x16&p1,const char*Kslot,const bf16x8*qr,int r32,int hi){
  const char*kb=Kslot+hi*1024+r32*16;
  #pragma unroll
  for(int d0=0;d0<4;++d0){
    const bf16x8 b0=*reinterpret_cast<const bf16x8*>(kb+d0*2048);
    const bf16x8 b1=*reinterpret_cast<const bf16x8*>(kb+d0*2048+512);
    p0=__builtin_amdgcn_mfma_f32_32x32x16_bf16(b0,qr[d0],p0,0,0,0);p1=__builtin_amdgcn_mfma_f32_32x32x16_bf16(b1,qr[d0],p1,0,0,0);}
}
typedef __attribute__((address_space(3))) const char* lds_cptr;
typedef short v4i16_t __attribute__((ext_vector_type(4)));
__device__ __forceinline__ void kload8(bf16x8*kf,lds_cptr kp){
  kf[0]=*(const __attribute__((address_space(3))) bf16x8*)(kp);      kf[1]=*(const __attribute__((address_space(3))) bf16x8*)(kp+512);
  kf[2]=*(const __attribute__((address_space(3))) bf16x8*)(kp+2048); kf[3]=*(const __attribute__((address_space(3))) bf16x8*)(kp+2560);
  kf[4]=*(const __attribute__((address_space(3))) bf16x8*)(kp+4096); kf[5]=*(const __attribute__((address_space(3))) bf16x8*)(kp+4608);
  kf[6]=*(const __attribute__((address_space(3))) bf16x8*)(kp+6144); kf[7]=*(const __attribute__((address_space(3))) bf16x8*)(kp+6656);
}
__device__ __forceinline__ void kload2(bf16x8*kf,lds_cptr kp,int j){ kf[2*j]=*(const __attribute__((address_space(3))) bf16x8*)(kp+j*2048); kf[2*j+1]=*(const __attribute__((address_space(3))) bf16x8*)(kp+j*2048+512); }
__device__ __forceinline__ s16x4 vtr(lds_cptr p){ return __builtin_bit_cast(s16x4,__builtin_amdgcn_ds_read_tr16_b64_v4i16((__attribute__((address_space(3))) v4i16_t*)p)); }
__device__ __forceinline__ float rowmax(const f32x16&p0,const f32x16&p1){
  float a=max3f(p0[0],p0[1],p1[0]),b=max3f(p0[2],p0[3],p1[1]);a=max3f(a,p1[2],p1[3]);
  #pragma unroll
  for(int r=4;r<16;r+=4){a=max3f(a,p0[r],p0[r+1]);b=max3f(b,p0[r+2],p0[r+3]);a=max3f(a,p1[r],p1[r+1]);b=max3f(b,p1[r+2],p1[r+3]);}
  const float m=max2f(a,b);
  auto rr=__builtin_amdgcn_permlane32_swap(__float_as_uint(m),__float_as_uint(m),false,false);
  return max2f(__uint_as_float(rr[0]),__uint_as_float(rr[1]));
}
__device__ __forceinline__ void pv(f32x16*o,int vb,bf16x8 pa0,bf16x8 pa1,bf16x8 pa2,bf16x8 pa3){
  #pragma unroll
  for(int d0=0;d0<2;++d0){s16x4 lo[4],hi[4];
    #pragma unroll
    for(int ks=0;ks<4;++ks){
      asm volatile("ds_read_b64_tr_b16 %0,%1 offset:%c2":"=&v"(lo[ks]):"v"(vb),"i"(d0*4096+ks*1024):"memory");
      asm volatile("ds_read_b64_tr_b16 %0,%1 offset:%c2":"=&v"(hi[ks]):"v"(vb),"i"(d0*4096+ks*1024+512):"memory");}
    asm volatile("s_waitcnt lgkmcnt(0)":::"memory");SBAR();
    #define PK(k) (bf16x8){lo[k][0],lo[k][1],lo[k][2],lo[k][3],hi[k][0],hi[k][1],hi[k][2],hi[k][3]}
    o[d0]=__builtin_amdgcn_mfma_f32_32x32x16_bf16(pa0,PK(0),o[d0],0,0,0);
    o[d0]=__builtin_amdgcn_mfma_f32_32x32x16_bf16(pa1,PK(1),o[d0],0,0,0);
    o[d0]=__builtin_amdgcn_mfma_f32_32x32x16_bf16(pa2,PK(2),o[d0],0,0,0);
    o[d0]=__builtin_amdgcn_mfma_f32_32x32x16_bf16(pa3,PK(3),o[d0],0,0,0);
    #undef PK
  }
}

#ifndef ATTN_STORE16
#define ATTN_STORE16(p,v) (*(u32x4*)(p)=(v))
#endif
__device__ __forceinline__ void unit_qk_offsets(int vv,int ii,long&qo,long&ko){
  int q_,t_,qc_,kc_; long rb;
  if(ii<8){ const int s=vv&7,bhv=(vv>>3)+32*(ii>>2),i4=ii&3,b=bhv>>4,h=(bhv>>2)&3,c=(bhv>>1)&1;
    q_=(i4==0)?s:(i4==1)?15-s:(i4==2)?16+s:31-s; t_=0; rb=(long)b*SEQ; qc_=768+h*128+c*64; kc_=1280+h*128+c*64; }
  else{ const int ui=vv*4+(ii-8),hq=(ui>>5)&7,b=ui>>8; q_=ui&31; t_=q_>0?4*q_-2:0; rb=(long)b*SEQ; qc_=hq*64; kc_=512+(hq>>2)*64; }
  qo=qc_+(rb+(long)q_*QB)*PIN; ko=kc_+(rb+(long)t_*KVBLK)*PIN;
}
template<int THRL> __device__ __forceinline__ void attn_unit(long rowbase,int qb,int t0,bool WIN,bool NOMAX,const bf16*Qc,const bf16*__restrict__ Kc,const bf16*__restrict__ Vc,bf16*Oc,float s2,float sink2,char*shm,
    bf16x8 (&qr)[4],bool pref,const bf16*qkvb,int vn,int in_){
  int tid=threadIdx.x; asm volatile("":"+v"(tid)); const int lane=tid&63,r32=lane&31,hi=lane>>5; const int wid=__builtin_amdgcn_readfirstlane(tid>>6);
  const int q0=qb*QB;
  const bf16*Qw=Qc+(rowbase+q0+wid*QBLK)*PIN;
  const bf16*Kh=Kc+(rowbase+(long)t0*KVBLK)*PIN,*Vh=Vc+(rowbase+(long)t0*KVBLK)*PIN;
  const unsigned lds0=(unsigned)(uintptr_t)shm;
  float*wsf=(float*)(shm+LDS_WS)+wid*64;
  const bf16*ksrc=Kh+(long)lane*PIN+wid*8;
  const bf16*vsrc=Vh+(long)(16*(wid&3)+(lane>>2))*PIN+(wid>>2)*32+(lane&3)*8;
  const unsigned kdst=lds0+LDS_K+wid*1024, vdst=lds0+LDS_V+wid*1024;
  #define DMA_K(t,slot) glds16(ksrc+(long)(t)*KVBLK*PIN,(unsigned)__builtin_amdgcn_readfirstlane(kdst+(slot)))
  #define DMA_V(t,slot) glds16(vsrc+(long)(t)*KVBLK*PIN,(unsigned)__builtin_amdgcn_readfirstlane(vdst+(slot)))
  const int vb0=(int)(lds0+LDS_V)+((lane>>4)&1)*32+(lane&3)*8+(4*hi+((lane&15)>>2))*64;
  const char*Kbase=shm+LDS_K; bf16x8 kf[8];
  const lds_cptr shm3=(lds_cptr)shm; const lds_cptr kp0=shm3+LDS_K+hi*1024+r32*16; const lds_cptr vp0=shm3+LDS_V+((lane>>4)&1)*32+(lane&3)*8+(4*hi+((lane&15)>>2))*64;
  const int NT=(q0+QB)/KVBLK-t0;
  if(!pref){ DMA_K(0,0);DMA_V(0,0);DMA_K(1,SLOTB);
    _Pragma("unroll") for(int d0=0;d0<4;++d0)qr[d0]=*reinterpret_cast<const bf16x8*>(&Qw[(long)r32*PIN+d0*16+hi*8]);
  } else { DMA_V(0,0); }
  float mhat=0.f,l_reg=0.f;f32x16 o[2];o[0]=f32x16{};o[1]=f32x16{};
  const int qrel=q0-t0*KVBLK+wid*QBLK+r32;
  const float qb2=s2*(float)(qrel-4*hi);
  #define CINIT(C0,C1,btl) do{ const float b_=(btl); const float s2b_=s2+s2, s2c_=s2b_+s2; \
    _Pragma("unroll") for(int j_=0;j_<4;++j_){ const float e0_=__builtin_fmaf(s2,(float)(8*j_),b_), e1_=__builtin_fmaf(s2,(float)(8*j_+32),b_); \
      C0[4*j_]=e0_; C0[4*j_+1]=fadd_s(e0_,s2); C0[4*j_+2]=fadd_s(e0_,s2b_); C0[4*j_+3]=fadd_s(e0_,s2c_); \
      C1[4*j_]=e1_; C1[4*j_+1]=fadd_s(e1_,s2); C1[4*j_+2]=fadd_s(e1_,s2b_); C1[4*j_+3]=fadd_s(e1_,s2c_); } }while(0)
  #define CMASK(P0,P1,t) do{ if(WIN||(t)>=NT-4)gmask(P0,P1,64*(t),qrel,hi,WIN);}while(0)
  bool resc=false;
  #define START(P0,P1) do{ resc=false; \
    if(!NOMAX){ const float rm=rowmax(P0,P1); const float dl=__builtin_fmaxf(rm,0.f);     \
      mhat=fadd_s(mhat,dl); \
      _Pragma("unroll") for(int r=0;r<16;++r){P0[r]=fsub_s(P0[r],dl);P1[r]=fsub_s(P1[r],dl);} } \
    _Pragma("unroll") for(int r=0;r<16;++r)P0[r]=__builtin_amdgcn_exp2f(P0[r]); }while(0)
  #define RESC() do{ if(resc){ asm volatile("s_waitcnt lgkmcnt(0)":::"memory"); \
      _Pragma("unroll") for(int d_=0;d_<2;++d_) _Pragma("unroll") for(int r=0;r<16;++r)o[d_][r]*=wsf[crow(r,hi)]; } }while(0)
  f32x16 pA0,pA1,pB0,pB1;
  int sl_prev=0,sl_cur=0,sl_next=SLOTB;
  #define ROT() do{sl_prev=sl_cur;sl_cur=sl_next;sl_next=(sl_next==(NSLOT-1)*SLOTB)?0:sl_next+SLOTB;}while(0)
  if(!pref){ DMA_K(2,2*SLOTB);
    WAIT_BAR(3); }
  else { WAIT_BAR(5); }
  CINIT(pA0,pA1,-qb2); qkt(pA0,pA1,Kbase,qr,r32,hi);asm volatile("s_nop 15\n\ts_nop 7":"+v"(pA0),"+v"(pA1));CMASK(pA0,pA1,0);
  START(pA0,pA1);
  _Pragma("unroll") for(int r=0;r<16;++r)pA1[r]=__builtin_amdgcn_exp2f(pA1[r]);
  WAIT_BAR(0);
  DMA_K(3,0);DMA_V(1,SLOTB);
  ROT();
  kload8(kf,kp0+sl_cur);
  CINIT(pB0,pB1,__builtin_fmaf(s2,64.f,-qb2)-mhat); asm volatile("":"+v"(pB0)); asm volatile("":"+v"(pB1));
  WAIT_BAR(2);
  s16x4 vlo[8],vhi[8]; u32x4 pw0,pw1,pw2,pw3;
  #define PKW(P,B) cvtpk_s(P[B],P[B+1])
  #define PAF(k) __builtin_bit_cast(bf16x8,pw##k)
  #define VFR(i) (bf16x8){vlo[i][0],vlo[i][1],vlo[i][2],vlo[i][3],vhi[i][0],vhi[i][1],vhi[i][2],vhi[i][3]}
  #define PIN(x) asm volatile("":"+v"(x))
  #define MX3(a,b,c) __builtin_fmaxf(__builtin_fmaxf((a),(b)),(c))
  #define GAPA(MF,A0,A1,A2,A3,W0,W1,PW) do{ MF; sacc+=A0; sacc+=A1; sacc+=A2; sacc+=A3; PIN(sacc); W0; W1; PIN(PW); SBAR(); }while(0)
  #define EX(v) __builtin_amdgcn_exp2f(v)
  #define GAPB(MF,X,B) do{ MF; X[B]=EX(X[B]); X[B+1]=EX(X[B+1]); X[B+2]=EX(X[B+2]); X[B+3]=EX(X[B+3]); PIN(X); SBAR(); }while(0)
  #define VRD(i) do{ vlo[i]=vtr(vp_+(((i)>>2)*4096+((i)&3)*1024)); vhi[i]=vtr(vp_+(((i)>>2)*4096+((i)&3)*1024+512)); }while(0)
  #define KRD(G,j) do{ if(G){ kload2(kf,kp0+sl_next,j); SBAR(); } }while(0)
  #define STEP(C0,C1,P0,P1,t,GK,GV,GL) do{ SBAR();     \
    const lds_cptr vp_=vp0+sl_prev; \
    VRD(0); SBAR(); float sacc=(P0[0]+P0[1]); \
    GAPA(C0=__builtin_amdgcn_mfma_f32_32x32x16_bf16(kf[0],qr[0],C0,0,0,0), P0[2],P0[3],P0[4],P0[5],     pw0[0]=PKW(P0,0), pw0[1]=PKW(P0,2), pw0); \
    VRD(4); SBAR(); GAPA(C1=__builtin_amdgcn_mfma_f32_32x32x16_bf16(kf[1],qr[0],C1,0,0,0), P0[6],P0[7],P0[8],P0[9],     pw0[2]=PKW(P0,4), pw0[3]=PKW(P0,6), pw0); \
    VRD(1); SBAR(); GAPA(C0=__builtin_amdgcn_mfma_f32_32x32x16_bf16(kf[2],qr[1],C0,0,0,0),   P0[10],P0[11],P0[12],P0[13], pw1[0]=PKW(P0,8), pw1[1]=PKW(P0,10), pw1); \
    VRD(5); SBAR(); GAPA(C1=__builtin_amdgcn_mfma_f32_32x32x16_bf16(kf[3],qr[1],C1,0,0,0),   P0[14],P0[15],P1[0],P1[1],   pw1[2]=PKW(P0,12),pw1[3]=PKW(P0,14), pw1); \
    VRD(2); SBAR(); GAPA(C0=__builtin_amdgcn_mfma_f32_32x32x16_bf16(kf[4],qr[2],C0,0,0,0),   P1[2],P1[3],P1[4],P1[5],     pw2[0]=PKW(P1,0), pw2[1]=PKW(P1,2), pw2); \
    VRD(6); SBAR(); GAPA(C1=__builtin_amdgcn_mfma_f32_32x32x16_bf16(kf[5],qr[2],C1,0,0,0),   P1[6],P1[7],P1[8],P1[9],     pw2[2]=PKW(P1,4), pw2[3]=PKW(P1,6), pw2); \
    VRD(3); SBAR(); GAPA(C0=__builtin_amdgcn_mfma_f32_32x32x16_bf16(kf[6],qr[3],C0,0,0,0),   P1[10],P1[11],P1[12],P1[13], pw3[0]=PKW(P1,8), pw3[1]=PKW(P1,10), pw3); \
    VRD(7); SBAR(); GAPA(C1=__builtin_amdgcn_mfma_f32_32x32x16_bf16(kf[7],qr[3],C1,0,0,0),   P1[14],P1[15],0.f,0.f,       pw3[2]=PKW(P1,12),pw3[3]=PKW(P1,14), pw3); \
    l_reg+=sacc; \
    if(GK){DMA_K((t)+3,sl_cur);} if(GV){DMA_V((t)+1,sl_next);} \
    CMASK(C0,C1,t); \
    if(!NOMAX){ float a=MX3(C0[0],C0[1],C1[0]),b=MX3(C0[2],C0[3],C1[1]); a=MX3(a,C1[2],C1[3]); \
      _Pragma("unroll") for(int r=4;r<16;r+=4){a=MX3(a,C0[r],C0[r+1]);b=MX3(b,C0[r+2],C0[r+3]);a=MX3(a,C1[r],C1[r+1]);b=MX3(b,C1[r+2],C1[r+3]);} \
      float rm=__builtin_fmaxf(a,b); { auto rr=__builtin_amdgcn_permlane32_swap(__float_as_uint(rm),__float_as_uint(rm),false,false); rm=__builtin_fmaxf(__uint_as_float(rr[0]),__uint_as_float(rr[1])); } \
      resc=false; \
      if(__builtin_expect(__any(rm>(float)THRL),0)){ const float dl=__builtin_fmaxf(rm,0.f); mhat+=dl; \
        _Pragma("unroll") for(int r=0;r<16;++r){C0[r]-=dl;C1[r]-=dl;} \
        const float f=__builtin_amdgcn_exp2f(-dl); l_reg*=f; if(hi==0)wsf[r32]=f; resc=true; } } else resc=false; \
    SBAR(); \
    GAPB(o[0]=__builtin_amdgcn_mfma_f32_32x32x16_bf16(PAF(0),VFR(0),o[0],0,0,0), C0,0); \
    GAPB(o[1]=__builtin_amdgcn_mfma_f32_32x32x16_bf16(PAF(0),VFR(4),o[1],0,0,0), C0,4); \
    KRD(GL,0); GAPB(o[0]=__builtin_amdgcn_mfma_f32_32x32x16_bf16(PAF(1),VFR(1),o[0],0,0,0), C0,8); \
    KRD(GL,1); GAPB(o[1]=__builtin_amdgcn_mfma_f32_32x32x16_bf16(PAF(1),VFR(5),o[1],0,0,0), C0,12); \
    KRD(GL,2); GAPB(o[0]=__builtin_amdgcn_mfma_f32_32x32x16_bf16(PAF(2),VFR(2),o[0],0,0,0), C1,0); \
    KRD(GL,3); GAPB(o[1]=__builtin_amdgcn_mfma_f32_32x32x16_bf16(PAF(2),VFR(6),o[1],0,0,0), C1,4); \
    GAPB(o[0]=__builtin_amdgcn_mfma_f32_32x32x16_bf16(PAF(3),VFR(3),o[0],0,0,0), C1,8); \
    GAPB(o[1]=__builtin_amdgcn_mfma_f32_32x32x16_bf16(PAF(3),VFR(7),o[1],0,0,0), C1,12); \
    CINIT(P0,P1,__builtin_fmaf(s2,(float)(64*((t)+1)),-qb2)-mhat); PIN(P0); PIN(P1);     \
    }while(0)
  int t=1;
  #undef CMASK
  #define CMASK(P0,P1,t) do{}while(0)
  for(;t+5<NT;t+=2){
    STEP(pB0,pB1,pA0,pA1,t,true,true,true);     WAIT_BAR(2); RESC(); ROT();
    STEP(pA0,pA1,pB0,pB1,t+1,true,true,true);   WAIT_BAR(2); RESC(); ROT();
  }
  #undef CMASK
  #define CMASK(P0,P1,t) do{ if(WIN||(t)>=NT-4)gmask(P0,P1,64*(t),qrel,hi,WIN);}while(0)
  #define ENDW(tt) do{ if((tt)+3<NT){WAIT_BAR(2);} else if((tt)+2<NT){WAIT_BAR(1);} else {WAIT_BAR(0);} }while(0)
  for(;t+1<NT;t+=2){
    STEP(pB0,pB1,pA0,pA1,t,(t+3<NT),(t+1<NT),(t+1<NT));       ENDW(t);   RESC(); ROT();
    STEP(pA0,pA1,pB0,pB1,t+1,(t+4<NT),(t+2<NT),(t+2<NT));     ENDW(t+1); RESC(); ROT();
  }
  STEP(pB0,pB1,pA0,pA1,NT-1,false,false,false); RESC();
  if(in_>=0){ long qo,ko; unit_qk_offsets(vn,in_,qo,ko);
    const bf16*ksn=qkvb+ko+(long)lane*PIN+wid*8;
    glds16(ksn,(unsigned)__builtin_amdgcn_readfirstlane(kdst)); glds16(ksn+(long)KVBLK*PIN,(unsigned)__builtin_amdgcn_readfirstlane(kdst+SLOTB)); glds16(ksn+(long)2*KVBLK*PIN,(unsigned)__builtin_amdgcn_readfirstlane(kdst+2*SLOTB));
    const bf16*Qwn=qkvb+qo+(long)(wid*QBLK)*PIN;
    _Pragma("unroll") for(int d0=0;d0<4;++d0)qr[d0]=*reinterpret_cast<const bf16x8*>(&Qwn[(long)r32*PIN+d0*16+hi*8]); }
  { float sacc=pB0[0]+pB0[1]; _Pragma("unroll") for(int r=2;r<16;++r)sacc+=pB0[r]; _Pragma("unroll") for(int r=0;r<16;++r)sacc+=pB1[r]; l_reg+=sacc;
    pw0=(u32x4){PKW(pB0,0),PKW(pB0,2),PKW(pB0,4),PKW(pB0,6)};pw1=(u32x4){PKW(pB0,8),PKW(pB0,10),PKW(pB0,12),PKW(pB0,14)};pw2=(u32x4){PKW(pB1,0),PKW(pB1,2),PKW(pB1,4),PKW(pB1,6)};pw3=(u32x4){PKW(pB1,8),PKW(pB1,10),PKW(pB1,12),PKW(pB1,14)};
    SBAR(); pv(o,vb0+sl_cur,PAF(0),PAF(1),PAF(2),PAF(3)); }
  #undef PKW
  #undef PAF
  #undef VFR
  #undef PIN
  #undef MX3
  #undef GAPA
  #undef GAPB
  #undef EX
  #undef VRD
  #undef KRD
  #undef STEP
  #undef ENDW
  {auto rr=__builtin_amdgcn_permlane32_swap(__float_as_uint(l_reg),__float_as_uint(l_reg),false,false);l_reg=__uint_as_float(rr[0])+__uint_as_float(rr[1]);}
  l_reg+=__builtin_amdgcn_exp2f(sink2-mhat);
  if(hi==0)wsf[32+r32]=l_reg;asm volatile("s_waitcnt lgkmcnt(0)":::"memory");
  float rli[16];
  #pragma unroll
  for(int r=0;r<16;++r)rli[r]=__builtin_amdgcn_rcpf(wsf[32+crow(r,hi)]);
  bf16*Ow=Oc+(rowbase+q0+wid*QBLK)*POUT;
  { bf16*stg=(bf16*)(shm+LDS_OST)+wid*2048;
    #pragma unroll
    for(int r=0;r<16;++r){const int orow=crow(r,hi);
      #pragma unroll
      for(int d0=0;d0<2;++d0)stg[orow*64+d0*32+r32]=__float2bfloat16(o[d0][r]*rli[r]);}
    asm volatile("s_waitcnt lgkmcnt(0)":::"memory");
    #pragma unroll
    for(int i=0;i<4;++i){const int row=i*8+(lane>>3),ch=lane&7; const u32x4 v=*(const u32x4*)(stg+row*64+ch*8); ATTN_STORE16(Ow+(long)row*POUT+ch*8,v);} }
  asm volatile("s_waitcnt lgkmcnt(0)\n\ts_barrier":::"memory");
  #undef DMA_K
  #undef DMA_V
  #undef CMASK
  #undef START
  #undef RESC
  #undef ROT
  #undef CINIT
}
constexpr int ATTN_LDS_BYTES=LDS_BYTES;
#undef SBAR
#undef WAIT_BAR
}
constexpr int NWAVES = 8;
constexpr int BATCH = 4, SEQ = 8192, DM = 1024, DEPTH = 4, M = BATCH * SEQ;
constexpr int INC = 4352, FFH = 2816, NQKV = 2304, NGATE = 2048;
constexpr size_t MiB = 1u << 20;
constexpr size_t WS_WIN = 0, WS_WB = 9 * MiB, WS_WO = 11 * MiB, WS_W1 = 13 * MiB, WS_W2 = 24 * MiB;
constexpr size_t WS_PSS = 30 * MiB;
constexpr size_t WS_QKV = 32 * MiB;
constexpr size_t WS_GATE = 176 * MiB;
constexpr size_t WS_ACT = 32 * MiB;
constexpr size_t WS_OA = 304 * MiB, WS_OB = 336 * MiB;
constexpr size_t WS_XB = 434 * MiB;
constexpr size_t WS_OD0 = 368 * MiB, WS_OD1 = 400 * MiB;
constexpr size_t WS_MRG = 368 * MiB;
constexpr size_t WS_END = 432 * MiB;
static_assert((DEPTH & 1) == 0 && WS_WIN + (size_t)INC * DM * 2 <= WS_WB && WS_W1 + (size_t)2 * FFH * DM * 2 <= WS_W2 && WS_W2 + (size_t)DM * FFH * 2 <= WS_PSS && WS_QKV + (size_t)M * NQKV * 2 <= WS_GATE && WS_GATE + (size_t)M * NGATE * 2 <= WS_OA && WS_ACT + (size_t)M * FFH * 2 <= WS_OA, "ws map");
constexpr int RING_BYTES = 131072, LDS_BYTES = 147456;
#define GAS __attribute__((address_space(1)))
#define LAS __attribute__((address_space(3)))
typedef unsigned short bf16;
typedef unsigned v4u __attribute__((ext_vector_type(4)));
typedef float f32x4 __attribute__((ext_vector_type(4)));
#define LDS_WAIT() asm volatile("s_waitcnt lgkmcnt(0)" ::: "memory")
__device__ __forceinline__ unsigned f2bf(float f) { unsigned u = __builtin_bit_cast(unsigned, f); return (u + 0x7fffu + ((u >> 16) & 1u)) >> 16; }
__device__ __forceinline__ unsigned pk2(float lo, float hi) { return f2bf(lo) | (f2bf(hi) << 16); }
__device__ __forceinline__ float wave_sum(float v) {
#pragma unroll
    for (int o = 1; o < 64; o <<= 1) v += __shfl_xor(v, o);
    return v;
}
__device__ __forceinline__ void transpose_item(const float* W, int ldw, const float* gain, bf16* WT, int K, int dst_row0, int k0, int n0, LAS float* scr, int lane) {
    float v[32];
#pragma unroll
    for (int i = 0; i < 32; ++i) { const int kk = 2 * i + (lane >> 5); v[i] = W[(size_t)(k0 + kk) * ldw + n0 + (lane & 31)]; }
    if (gain) {
#pragma unroll
        for (int i = 0; i < 32; ++i) v[i] *= gain[k0 + 2 * i + (lane >> 5)]; }
#pragma unroll
    for (int i = 0; i < 32; ++i) scr[(2 * i + (lane >> 5)) * 33 + (lane & 31)] = v[i];
    LDS_WAIT(); asm volatile("" ::: "memory");
    const int c = lane & 7;
#pragma unroll
    for (int j = 0; j < 4; ++j) { const int n = (lane >> 3) + 8 * j; const LAS float* s = scr + (8 * c) * 33 + n;
        v4u o; o.x = pk2(s[0 * 33], s[1 * 33]); o.y = pk2(s[2 * 33], s[3 * 33]); o.z = pk2(s[4 * 33], s[5 * 33]); o.w = pk2(s[6 * 33], s[7 * 33]);
        *(GAS v4u*)(WT + (size_t)(dst_row0 + n) * K + k0 + 8 * c) = o; }
    LDS_WAIT(); asm volatile("" ::: "memory");
}
#define RLX_AGENT __ATOMIC_RELAXED, __HIP_MEMORY_SCOPE_AGENT
#define XB_TMO      128
#define XB_XCNT(j)  (256  + 64 * (j))
#define XB_XSUB(j)  (1280 + 64 * (j))
#define XB_XGEN(j)  (2304 + 64 * (j))
#define XB_TOP      3328
#define XB_TOPGEN   3392
#define XCD_BAR_WORDS 3456
#define XB_SPIN_CAP (1u << 18)

__device__ __forceinline__ unsigned xb_ld(unsigned* p)              { return __hip_atomic_load(p, __ATOMIC_RELAXED, __HIP_MEMORY_SCOPE_AGENT); }
__device__ __forceinline__ unsigned xb_add(unsigned* p, unsigned v) { return __hip_atomic_fetch_add(p, v, __ATOMIC_RELAXED, __HIP_MEMORY_SCOPE_AGENT); }
__device__ __forceinline__ unsigned xb_xcc_id() { return (unsigned)__builtin_amdgcn_s_getreg((3 << 11) | 20) & 0xFu; }
#define XB_SPIN(cond, bar) do { unsigned _sp = 0; while (cond) { __builtin_amdgcn_s_sleep(1); \
    if ((++_sp & 255u) == 0u) { if (xb_ld(&(bar)[XB_TMO])) break; if (_sp > XB_SPIN_CAP) { atomicAdd(&(bar)[XB_TMO], 1u); break; } } } } while (0)

struct XcdBarrier {
    unsigned* bar; unsigned x;
    volatile LAS unsigned* st;
};

__device__ __forceinline__ XcdBarrier xcd_barrier_post(unsigned* bar, volatile LAS unsigned* st) {
    XcdBarrier b; b.bar = bar; b.x = xb_xcc_id(); b.st = st;
    if (threadIdx.x == 0) (void)xb_add(&bar[XB_XCNT(b.x)], 1u);
    return b;
}
__device__ __forceinline__ void xcd_barrier_complete(unsigned* bar, unsigned x, unsigned& nloc, unsigned& nx) {
    const unsigned G = gridDim.x * gridDim.y * gridDim.z;
    unsigned sum, cnt, mine, sp = 0u;
    for (;;) {
        sum = 0u; cnt = 0u; mine = 0u;
#pragma unroll
        for (unsigned j = 0; j < 16; ++j) { const unsigned c = xb_ld(&bar[XB_XCNT(j)]); sum += c; cnt += (c > 0u) ? 1u : 0u; mine = (j == x) ? c : mine; }
        if (sum == G) break;
        __builtin_amdgcn_s_sleep(1);
        if ((++sp & 255u) == 0u) { if (xb_ld(&bar[XB_TMO])) break; if (sp > XB_SPIN_CAP) { atomicAdd(&bar[XB_TMO], 1u); break; } }
    }
    nloc = mine > 0u ? mine : 1u; nx = cnt > 0u ? cnt : 1u;
}

__device__ __forceinline__ void xcd_barrier(const XcdBarrier& b) {
    asm volatile("s_waitcnt vmcnt(0)" ::: "memory");
    __syncthreads();
    if (threadIdx.x == 0) {
        unsigned* bar = b.bar;
        __builtin_amdgcn_s_waitcnt(0);
        unsigned nloc = b.st[0], nx = b.st[1];
        if (nloc == 0u) { xcd_barrier_complete(bar, b.x, nloc, nx); b.st[0] = nloc; b.st[1] = nx; }
        const unsigned old = xb_add(&bar[XB_XSUB(b.x)], 1u);
        const unsigned gen = old / nloc;
        if (old + 1u == (gen + 1u) * nloc) {
            __builtin_amdgcn_fence(__ATOMIC_RELEASE, "agent");
            asm volatile("s_waitcnt vmcnt(0)" ::: "memory");
            const unsigned og = xb_add(&bar[XB_TOP], 1u);
            const unsigned tg = og / nx;
            if (og + 1u == (tg + 1u) * nx) xb_add(&bar[XB_TOPGEN], 1u);
            else XB_SPIN(xb_ld(&bar[XB_TOPGEN]) == tg, bar);
            __builtin_amdgcn_fence(__ATOMIC_ACQUIRE, "agent");
            xb_add(&bar[XB_XGEN(b.x)], 1u);
            asm volatile("s_waitcnt vmcnt(0)" ::: "memory");
        } else {
            XB_SPIN(xb_ld(&bar[XB_XGEN(b.x)]) == gen, bar);
            __builtin_amdgcn_fence(__ATOMIC_ACQUIRE, "agent");
            asm volatile("s_waitcnt vmcnt(0)" ::: "memory");
        }
    }
    __syncthreads();
}

constexpr size_t WS_CTL = WS_END, CTL_ZERO_BYTES = 65536;
constexpr int CW_BAR = 1024;
constexpr int MISC_OFF = RING_BYTES + 320;
struct Args { const float* in[14]; float* out; unsigned char* ws; };

typedef const __attribute__((address_space(4))) Args* kargs_t;
#define WBASE(l) (((l) & 1) ? ap->ws : (unsigned char*)ap->out)
#define WB(l, off) ((bf16*)(WBASE(l) + (off)))
__device__ __forceinline__ void convert_weights(kargs_t ap, int lw, LAS float* scr, int lane, int it0, int stride) {
    const int l = lw; unsigned char* wb = WBASE(lw);
    bf16* WINt = (bf16*)(wb + WS_WIN); bf16* WBt = (bf16*)(wb + WS_WB); bf16* WOt = (bf16*)(wb + WS_WO); bf16* W1t = (bf16*)(wb + WS_W1); bf16* W2t = (bf16*)(wb + WS_W2);
    const float* w_in = ap->in[1] + (size_t)l * DM * INC; const float* w_br = ap->in[3] + (size_t)l * 2 * 512 * DM; const float* w_o = ap->in[4] + (size_t)l * DM * DM;
    const float* w_1 = ap->in[12] + (size_t)l * DM * 2 * FFH; const float* w_2 = ap->in[13] + (size_t)l * FFH * DM;
    const float* g_mix = ap->in[5] + l * DM; const float* g_ffn = ap->in[6] + l * DM;
            constexpr int I_IN = (DM / 64) * (INC / 32), I_BR = (512 / 64) * (DM / 32), I_O = (DM / 64) * (DM / 32), I_1 = (DM / 64) * (2 * FFH / 32), I_2 = (FFH / 64) * (DM / 32);
    constexpr int NITEMS = I_IN + 2 * I_BR + I_O + I_1 + I_2;
    for (int it = it0; it < NITEMS; it += stride) {
        int r = it;
        if (r < I_IN) { const int nblk = INC / 32, kb = r / nblk, nb = r % nblk, n0 = 32 * nb; int dst = n0;
            if (n0 < 2304) { const int pn = n0 >> 8, lb = (n0 & 255) >> 5; dst = 256 * pn + 128 * (lb & 1) + 32 * (lb >> 1); }
            transpose_item(w_in, INC, g_mix, WINt, DM, dst, 64 * kb, n0, scr, lane); continue; } r -= I_IN;
        if (r < 2 * I_BR) { const int z = r / I_BR; r -= z * I_BR; const int nblk = DM / 32, kb = r / nblk, nb = r % nblk;
            transpose_item(w_br + (size_t)z * 512 * DM, DM, nullptr, WBt + (size_t)z * DM * 512, 512, 32 * nb, 64 * kb, 32 * nb, scr, lane); continue; } r -= 2 * I_BR;
        if (r < I_O) { const int nblk = DM / 32, kb = r / nblk, nb = r % nblk; transpose_item(w_o, DM, nullptr, WOt, DM, 32 * nb, 64 * kb, 32 * nb, scr, lane); continue; } r -= I_O;
        if (r < I_1) { const int nblk = 2 * FFH / 32, kb = r / nblk, nb = r % nblk, n0 = 32 * nb; int dst;
            if (n0 < FFH) dst = 256 * (n0 >> 7) + (n0 & 127); else { const int n1 = n0 - FFH; dst = 256 * (n1 >> 7) + 128 + (n1 & 127); }
            transpose_item(w_1, 2 * FFH, g_ffn, W1t, DM, dst, 64 * kb, n0, scr, lane); continue; } r -= I_1;
        { const int nblk = DM / 32, kb = r / nblk, nb = r % nblk; transpose_item(w_2, DM, nullptr, W2t, FFH, 32 * nb, 64 * kb, 32 * nb, scr, lane); }
    }
}

__global__ void __launch_bounds__(NWAVES * 64, 2) mk_fwd(Args args) {
    extern __shared__ __attribute__((aligned(16))) unsigned char lds[];
    cg::grid_group grid = cg::this_grid();
    LAS unsigned char* ldsp = (LAS unsigned char*)lds;
    for (int u = threadIdx.x; u < (LDS_BYTES - RING_BYTES) / 4; u += NWAVES * 64) ((LAS unsigned*)(ldsp + RING_BYTES))[u] = 0u;
    __syncthreads();
    const XcdBarrier bar = xcd_barrier_post((unsigned*)(args.ws + WS_CTL) + CW_BAR, (volatile LAS unsigned*)(ldsp + MISC_OFF) + 8);
    grid.sync();
    const int G = gridDim.x; const int bx = blockIdx.x; const int vcu = (G % 8 == 0) ? (bx % 8) * (G / 8) + bx / 8 : bx;
    const int NGW = G * NWAVES;
#define LANE_WAVE() int tid_ = threadIdx.x; asm volatile("" : "+v"(tid_)); const int lane = tid_ & 63, wave = __builtin_amdgcn_readfirstlane(tid_ >> 6), gw = vcu * NWAVES + wave;
#define KARGS() ({ kargs_t p_ = (kargs_t)__builtin_amdgcn_kernarg_segment_ptr(); asm volatile("" : "+s"(p_)); p_; })
#define WSP(T, off) ((T*)(ap->ws + (off)))
#define GRID_SYNC() xcd_barrier(bar)
#pragma clang loop unroll(disable)
    for (int l = 0; l < DEPTH; ++l) {
        if (l == 0) {
            LANE_WAVE();
            kargs_t ap = KARGS();
            convert_weights(ap, 0, (LAS float*)(ldsp + wave * 16384), lane, gw, NGW);
            {   bf16* XB = WSP(bf16, WS_XB); float* PSS = WSP(float, WS_PSS);
                for (int m0 = gw; m0 < M; m0 += 4 * NGW) {
                    f32x4 v[4][4];
#pragma unroll
                    for (int q = 0; q < 4; ++q) { const int m = m0 + q * NGW; const GAS f32x4* xr = (const GAS f32x4*)(ap->in[0] + (size_t)(m < M ? m : 0) * DM) + lane;
#pragma unroll
                        for (int j = 0; j < 4; ++j) v[q][j] = xr[64 * j]; }
#pragma unroll
                    for (int q = 0; q < 4; ++q) { const int m = m0 + q * NGW; float s = 0.f;
#pragma unroll
                        for (int j = 0; j < 4; ++j) s += (v[q][j].x * v[q][j].x + v[q][j].y * v[q][j].y) + (v[q][j].z * v[q][j].z + v[q][j].w * v[q][j].w);
                        s = wave_sum(s);
                        if (m < M) { GAS unsigned long long* o8 = (GAS unsigned long long*)(XB + (size_t)m * DM) + lane;
#pragma unroll
                            for (int j = 0; j < 4; ++j) o8[64 * j] = (unsigned long long)pk2(v[q][j].x, v[q][j].y) | ((unsigned long long)pk2(v[q][j].z, v[q][j].w) << 32);
                            if (lane < 4) PSS[(size_t)lane * M + m] = (lane == 0) ? s : 0.f; } }
                }
            }
            GRID_SYNC();
        }
        {
            kargs_t ap = KARGS();
            pg8::Gemm g{WSP(bf16, WS_XB), WB(l, WS_WIN), M, INC, DM, 0, 0}; pg8::StaticOrder S; S.init(M, INC, G, bx);
            pg8::EpiInProj E{WSP(bf16, WS_QKV), WSP(bf16, WS_GATE), WSP(float, WS_PSS), ap->in[7] + l * 128, ap->in[8] + l * 128, ap->in[2] + l * 2048};
            pg8::gemm_phase<pg8::EpiInProj, pg8::StaticOrder, true, true>(ldsp, g, S, E);
            if (l + 1 < DEPTH) {
                const int nun = (M / 256) * (INC / 256), first_idle = nun - (nun / G) * G; int ncv = G, icv = bx;
                if (first_idle > 0 && first_idle < G) { ncv = G - first_idle; icv = bx - first_idle; }
                if (icv >= 0) { LANE_WAVE(); (void)gw; convert_weights(KARGS(), l + 1, (LAS float*)(ldsp + wave * 16384), lane, icv * NWAVES + wave, ncv * NWAVES); }
            }
        }
        GRID_SYNC();
        {
            kargs_t ap = KARGS(); bf16* QKV = WSP(bf16, WS_QKV); bf16* OA = WSP(bf16, WS_OA); bf16* OD0 = WSP(bf16, WS_OD0); bf16* OD1 = WSP(bf16, WS_OD1);
            const float LOG2E = 1.4426950408889634f;
            bool nomax_swa, nomax_diff;
            { LANE_WAVE(); (void)gw; (void)wave;
              float a0 = fabsf(ap->in[7][l * 128 + lane]), a1 = fabsf(ap->in[7][l * 128 + 64 + lane]), d0 = fabsf(ap->in[8][l * 128 + lane]), d1 = fabsf(ap->in[8][l * 128 + 64 + lane]);
#pragma unroll
              for (int o = 1; o < 64; o <<= 1) { a0 = fmaxf(a0, __shfl_xor(a0, o)); a1 = fmaxf(a1, __shfl_xor(a1, o)); d0 = fmaxf(d0, __shfl_xor(d0, o)); d1 = fmaxf(d1, __shfl_xor(d1, o)); }
              nomax_swa = (8.0f * LOG2E * 1.02f * a0 * a1) <= 40.0f; nomax_diff = (8.0f * LOG2E * 1.02f * d0 * d1) <= 40.0f; }
            attn_body::bf16x8 qfr[4]; bool pref = false;
            for (int v = vcu; v < 256; v += G) {
                for (int i = 0; i < 12; ++i) {
                    long rowbase; int qb, t0, qc, kc, vc, oc; bool win; float s2, sink2; bf16* Ob;
                    if (i < 8) {
                        const int s = v & 7, bhv = (v >> 3) + 32 * (i >> 2), ii = i & 3, b = bhv >> 4, h = (bhv >> 2) & 3, c = (bhv >> 1) & 1, vh = bhv & 1;
                        qb = (ii == 0) ? s : (ii == 1) ? 15 - s : (ii == 2) ? 16 + s : 31 - s; t0 = 0; win = false; rowbase = (long)b * SEQ;
                        qc = 768 + h * 128 + c * 64; kc = 1280 + h * 128 + c * 64; vc = 1792 + h * 128 + vh * 64; oc = h * 128 + vh * 64; Ob = c ? OD1 : OD0;
                        s2 = exp2f(-8.0f * (float)(9 + h) / 12.0f) * LOG2E; sink2 = -INFINITY;
                    } else {
                        const int ui = v * 4 + (i - 8), hq = (ui >> 5) & 7, b = ui >> 8; qb = ui & 31; t0 = qb > 0 ? 4 * qb - 2 : 0; win = true; rowbase = (long)b * SEQ;
                        qc = hq * 64; kc = 512 + (hq >> 2) * 64; vc = 640 + (hq >> 2) * 64; oc = hq * 64; Ob = OA;
                        s2 = exp2f(-8.0f * (float)(1 + hq) / 12.0f) * LOG2E; sink2 = ap->in[9][l * 8 + hq] * LOG2E;
                    }
                    int vn = v, in = i + 1; if (in == 12) { in = 0; vn = v + G; }
                    if (vn >= 256) in = -1;
                    attn_body::attn_unit<60>(rowbase, qb, t0, win, win ? nomax_swa : nomax_diff, (const attn_body::bf16*)QKV + qc, (const attn_body::bf16*)QKV + kc, (const attn_body::bf16*)QKV + vc, (attn_body::bf16*)Ob + oc, s2, sink2, (char*)lds,
                        qfr, pref, (const attn_body::bf16*)QKV, vn, in);
                    pref = in >= 0;
                }
            }
        }
        GRID_SYNC();
        {
            LANE_WAVE();
            kargs_t ap = KARGS(); bf16* OD0 = WSP(bf16, WS_OD0); bf16* OD1 = WSP(bf16, WS_OD1); bf16* OB = WSP(bf16, WS_OB);
            const float lam_init = 0.8f - 0.6f * expf(-0.3f * (float)l);
            const float* lp = ap->in[10] + l * 256;
            const float lam = expf(wave_sum(lp[lane] * lp[64 + lane])) - expf(wave_sum(lp[128 + lane] * lp[192 + lane])) + lam_init;
            const float* sl = ap->in[11] + l * 128 + (8 * lane & 127);
            float gsc[8];
#pragma unroll
            for (int i = 0; i < 8; ++i) gsc[i] = sl[i] * (1.0f - lam_init);
            for (int m0 = gw; m0 < M; m0 += 4 * NGW) {
                v4u a[4], b[4];
#pragma unroll
                for (int j = 0; j < 4; ++j) { const int m = m0 + j * NGW; if (m < M) { a[j] = *(const GAS v4u*)(OD0 + (size_t)m * 512 + 8 * lane); b[j] = *(const GAS v4u*)(OD1 + (size_t)m * 512 + 8 * lane); } else { a[j] = (v4u){0u, 0u, 0u, 0u}; b[j] = a[j]; } }
#pragma unroll
                for (int j = 0; j < 4; ++j) { const int m = m0 + j * NGW;
                    float o[8];
#pragma unroll
                    for (int i = 0; i < 4; ++i) { o[2 * i] = __uint_as_float(a[j][i] << 16) - lam * __uint_as_float(b[j][i] << 16); o[2 * i + 1] = __uint_as_float(a[j][i] & 0xffff0000u) - lam * __uint_as_float(b[j][i] & 0xffff0000u); }
                    float ss = 0.f;
#pragma unroll
                    for (int i = 0; i < 8; ++i) ss += o[i] * o[i];
                    ss += __shfl_xor(ss, 1); ss += __shfl_xor(ss, 2); ss += __shfl_xor(ss, 4); ss += __shfl_xor(ss, 8);
                    const float rn = __builtin_amdgcn_rsqf(ss * (1.0f / 128.0f) + 1e-6f);
                    v4u w;
#pragma unroll
                    for (int i = 0; i < 4; ++i) w[i] = pk2(o[2 * i] * rn * gsc[2 * i], o[2 * i + 1] * rn * gsc[2 * i + 1]);
                    if (m < M) *(GAS v4u*)(OB + (size_t)m * 512 + 8 * lane) = w; }
            }
        }
        GRID_SYNC();
        {
            kargs_t ap = KARGS();
            pg8::Gemm g{WSP(bf16, WS_OA), WB(l, WS_WB), M, DM, 512, (size_t)(WS_OB - WS_OA), (size_t)DM * 512 * 2}; pg8::ZOrder S; S.S.init(M, DM, G, bx);
            pg8::EpiGateMerge E{WSP(bf16, WS_GATE), WSP(bf16, WS_MRG)};
            pg8::gemm_phase<pg8::EpiGateMerge, pg8::ZOrder, true, true>(ldsp, g, S, E);
        }
        GRID_SYNC();
        {
            kargs_t ap = KARGS(); float* out = ap->out;
            pg8::Gemm g{WSP(bf16, WS_MRG), WB(l, WS_WO), M, DM, DM, 0, 0}; pg8::StaticOrder S; S.init(M, DM, G, bx);
            pg8::EpiResid E{nullptr, WSP(bf16, WS_XB), WSP(float, WS_PSS), (LAS float*)(ldsp + RING_BYTES + 1024)}; (void)out;
            pg8::gemm_phase<pg8::EpiResid, pg8::StaticOrder, true, true>(ldsp, g, S, E);
        }
        GRID_SYNC();
        {
            kargs_t ap = KARGS();
            pg8::Gemm g{WSP(bf16, WS_XB), WB(l, WS_W1), M, 2 * FFH, DM, 0, 0}; pg8::StaticOrder S; S.init(M, 2 * FFH, G, bx);
            pg8::EpiSwiGLU E{WSP(bf16, WS_ACT), WSP(float, WS_PSS)};
            pg8::gemm_phase<pg8::EpiSwiGLU, pg8::StaticOrder, true, true>(ldsp, g, S, E);
        }
        GRID_SYNC();
        {
            kargs_t ap = KARGS(); float* out = ap->out;
            pg8::Gemm g{WSP(bf16, WS_ACT), WB(l, WS_W2), M, DM, FFH, 0, 0}; pg8::StaticOrder S; S.init(M, DM, G, bx);
            pg8::EpiResid E{l == DEPTH - 1 ? out : nullptr, WSP(bf16, WS_XB), WSP(float, WS_PSS), (LAS float*)(ldsp + RING_BYTES + 1024)};
            pg8::gemm_phase<pg8::EpiResid, pg8::StaticOrder, true, true>(ldsp, g, S, E);
        }
        GRID_SYNC();
    }
}

extern "C" void kernel_launch(void* const* d_in, const int* in_sizes, int n_in, void* d_out, int out_size, void* d_ws, size_t ws_size, hipStream_t stream) {
    static int grid = 0;
    if (grid == 0) {
        if (n_in != 14 || in_sizes[0] != M * DM || out_size != M * DM || ws_size < WS_XB + 64 * MiB) { fprintf(stderr, "kernel_launch: unexpected shapes (n_in %d, in0 %d, out %d, ws %zu); nothing launched\n", n_in, n_in > 0 ? in_sizes[0] : -1, out_size, ws_size); grid = -1; return; }
        int dev = 0, cus = 0, per_cu = 0;
        if (hipGetDevice(&dev) != hipSuccess || hipDeviceGetAttribute(&cus, hipDeviceAttributeMultiprocessorCount, dev) != hipSuccess) { grid = -1; return; }
        if (hipFuncSetAttribute((const void*)mk_fwd, hipFuncAttributeMaxDynamicSharedMemorySize, LDS_BYTES) != hipSuccess) { fprintf(stderr, "kernel_launch: hipFuncSetAttribute failed\n"); grid = -1; return; }
        if (hipOccupancyMaxActiveBlocksPerMultiprocessor(&per_cu, (const void*)mk_fwd, NWAVES * 64, LDS_BYTES) != hipSuccess || per_cu < 1) { fprintf(stderr, "kernel_launch: occupancy query says %d\n", per_cu); per_cu = 1; }
        (void)hipGetLastError();
        grid = cus * per_cu;
    }
    if (grid < 0) return;
    if (hipMemsetAsync((char*)d_ws + WS_CTL, 0, CTL_ZERO_BYTES, stream) != hipSuccess) { fprintf(stderr, "kernel_launch: hipMemsetAsync failed\n"); return; }
    Args a{};
    for (int i = 0; i < 14; ++i) a.in[i] = (const float*)d_in[i];
    a.out = (float*)d_out; a.ws = (unsigned char*)d_ws;
    void* kargs[] = {&a};
    hipError_t e = hipLaunchCooperativeKernel((const void*)mk_fwd, dim3(grid), dim3(NWAVES * 64), kargs, LDS_BYTES, stream);
    if (e != hipSuccess) fprintf(stderr, "cooperative launch failed: %s (grid %d)\n", hipGetErrorString(e), grid);
}
```

```cpp
#include <hip/hip_runtime.h>
#include <hip/hip_cooperative_groups.h>
#include <cstdio>
#include <cstdint>
namespace cg = cooperative_groups;
namespace pg8 {
#define PG8_LAS __attribute__((address_space(3)))
typedef unsigned short bf16_t;
typedef short bf16x8 __attribute__((ext_vector_type(8)));
typedef float f32x4 __attribute__((ext_vector_type(4)));
typedef unsigned u32x4 __attribute__((ext_vector_type(4)));
constexpr int BM = 256, BK = 64, HALF = 128, HTB = HALF * BK * 2  , STAGE_BYTES = 8 * HTB, NXCD = 8, WGM = 4;

__host__ __device__ __forceinline__ int lds_byte(int r, int c) { const int st = (r >> 4) * 2 + (c >> 5), rr = r & 15, cc = c & 31, ob = rr * 64 + cc * 2; return st * 1024 + (ob ^ (((ob >> 9) & 1) << 5)); }
__host__ __device__ __forceinline__ void stage_rc(int b, int& R, int& C) { const int st = b / 1024, sb = b % 1024, swz = sb ^ (((sb >> 9) & 1) << 5); R = (st >> 1) * 16 + swz / 64; C = (st & 1) * 32 + (swz % 64) / 2; }
__host__ __device__ __forceinline__ int perm32(int rho) { const int n = rho >> 4, i = rho & 15; return 8 * (i >> 2) + 4 * n + (i & 3); }

struct Unit { int pm, pn, z; };
struct Gemm { const bf16_t* A; const bf16_t* Bt; int M, N, K; size_t zA, zB; };

struct StaticOrder {
    int nM, nN, nwg, G, c;
    __host__ __device__ void init(int M, int N, int G_, int c_) { nM = M / BM; nN = N / BM; nwg = nM * nN; G = G_; c = c_; }
    __host__ __device__ bool next(int i, Unit& u) const {
        const long L = (long)i * G + c; if (L >= nwg) return false;
        int wgid = (int)L; { const int q = nwg / NXCD, r = nwg % NXCD, xcd = wgid % NXCD, off = wgid / NXCD; wgid = (xcd < r ? xcd * (q + 1) : r * (q + 1) + (xcd - r) * q) + off; }
        const int nig = WGM * nN, gid = wgid / nig, fm = gid * WGM, gsz = (nM - fm) < WGM ? (nM - fm) : WGM;
        u.pm = fm + ((wgid % nig) % gsz); u.pn = (wgid % nig) / gsz; u.z = 0; return true;
    }
    __device__ __forceinline__ void a_ready(const Unit&) const {}
    __device__ __forceinline__ void done(const Unit&) const {}
};

typedef float f32x2_t __attribute__((ext_vector_type(2))); typedef __bf16 bf16x2_t __attribute__((ext_vector_type(2)));
__device__ __forceinline__ unsigned cvt_pk_bf16(float lo, float hi) { f32x2_t v = {lo, hi}; bf16x2_t b = __builtin_convertvector(v, bf16x2_t); return __builtin_bit_cast(unsigned, b); }
__device__ __forceinline__ u32x4 pack8(const f32x4 a, const f32x4 b) { u32x4 w; w.x = cvt_pk_bf16(a[0], a[1]); w.y = cvt_pk_bf16(a[2], a[3]); w.z = cvt_pk_bf16(b[0], b[1]); w.w = cvt_pk_bf16(b[2], b[3]); return w; }
__device__ __forceinline__ float bflo(unsigned w) { return __uint_as_float(w << 16); }
__device__ __forceinline__ float bfhi(unsigned w) { return __uint_as_float(w & 0xffff0000u); }
constexpr float RMS_EPS = 1e-6f;
constexpr float QC2 = 0.125f * 1.4426950408889634f;
constexpr int PSS_M = 32768;
__device__ __forceinline__ float row_rstd(const float* pss, int r, int fq) {
    float s = pss[(size_t)fq * PSS_M + r];
    s += __shfl_xor(s, 16); s += __shfl_xor(s, 32);
    return __builtin_amdgcn_rsqf(s * (1.0f / 1024.0f) + RMS_EPS);
}
__device__ __forceinline__ void rows_rstd8(const float* pss, int row0, int fq, float (&rs)[2][4]) {
    float p[8], q[8];
#pragma unroll
    for (int k = 0; k < 8; ++k) p[k] = pss[(size_t)fq * PSS_M + row0 + (k >> 2) * HALF + (k & 3) * 16];
    asm volatile("" : "+v"(p[0]), "+v"(p[1]), "+v"(p[2]), "+v"(p[3]), "+v"(p[4]), "+v"(p[5]), "+v"(p[6]), "+v"(p[7]));
#pragma unroll
    for (int k = 0; k < 8; ++k) q[k] = __shfl_xor(p[k], 16);
    asm volatile("" : "+v"(q[0]), "+v"(q[1]), "+v"(q[2]), "+v"(q[3]), "+v"(q[4]), "+v"(q[5]), "+v"(q[6]), "+v"(q[7]));
#pragma unroll
    for (int k = 0; k < 8; ++k) p[k] += q[k];
#pragma unroll
    for (int k = 0; k < 8; ++k) q[k] = __shfl_xor(p[k], 32);
    asm volatile("" : "+v"(q[0]), "+v"(q[1]), "+v"(q[2]), "+v"(q[3]), "+v"(q[4]), "+v"(q[5]), "+v"(q[6]), "+v"(q[7]));
#pragma unroll
    for (int k = 0; k < 8; ++k) rs[k >> 2][k & 3] = __builtin_amdgcn_rsqf((p[k] + q[k]) * (1.0f / 1024.0f) + RMS_EPS);
}
struct EpiInProj {
    static constexpr bool PERM = true, AFTER_DRAIN = false;
    bf16_t* qkv; bf16_t* gate; const float* pss; const float* qkn_swa; const float* qkn_diff; const float* bgate;
    __device__ __forceinline__ bool keep(const Unit&) const { return false; }
    __device__ __forceinline__ void operator()(f32x4 (&acc)[2][2][4][2], const Unit& u, int wr, int wc, int fr, int fq) const {
        const int row0 = u.pm * BM + wr * 64 + fr;
        float rs[2][4];
        rows_rstd8(pss, row0, fq, rs);
        if (u.pn < 9) {
            const int lc0 = u.pn * 256 + wc * 64;
            const float* gp = nullptr; float sc = 1.f;
            if (lc0 < 512) { gp = qkn_swa; sc = QC2; } else if (lc0 < 640) { gp = qkn_swa + 64; } else if (lc0 < 768) { } else if (lc0 < 1280) { gp = qkn_diff; sc = QC2; } else if (lc0 < 1792) { gp = qkn_diff + 64; }
            f32x4 gv[2][2];
#pragma unroll
            for (int bj = 0; bj < 2; ++bj)
#pragma unroll
                for (int n = 0; n < 2; ++n) gv[bj][n] = gp ? *(const f32x4*)(gp + 32 * bj + 8 * fq + 4 * n) * sc : (f32x4){1.f, 1.f, 1.f, 1.f};
#pragma unroll
            for (int ai = 0; ai < 2; ++ai)
#pragma unroll
                for (int m = 0; m < 4; ++m) {
                    const int r = row0 + ai * HALF + m * 16; const float rstd = rs[ai][m];
                    float sc_row = rstd;
                    if (gp) { float ss = 0.f;
#pragma unroll
                        for (int bj = 0; bj < 2; ++bj)
#pragma unroll
                            for (int n = 0; n < 2; ++n) { const f32x4 q = acc[ai][bj][m][n] * acc[ai][bj][m][n]; ss += (q[0] + q[1]) + (q[2] + q[3]); }
                        ss += __shfl_xor(ss, 16); ss += __shfl_xor(ss, 32);
                        sc_row = rstd * __builtin_amdgcn_rsqf(ss * (rstd * rstd) * (1.0f / 64.0f) + RMS_EPS); }
                    bf16_t* rowp = qkv + (size_t)r * 2304 + lc0 + 8 * fq;
#pragma unroll
                    for (int bj = 0; bj < 2; ++bj) *(u32x4*)(rowp + 32 * bj) = pack8(acc[ai][bj][m][0] * sc_row * gv[bj][0], acc[ai][bj][m][1] * sc_row * gv[bj][1]);
                }
        } else {
            const int g0 = (u.pn - 9) * 256 + wc * 32 + 8 * fq;
            f32x4 bv[2][2];
#pragma unroll
            for (int bj = 0; bj < 2; ++bj)
#pragma unroll
                for (int n = 0; n < 2; ++n) bv[bj][n] = *(const f32x4*)(bgate + g0 + bj * HALF + 4 * n);
#pragma unroll
            for (int ai = 0; ai < 2; ++ai)
#pragma unroll
                for (int m = 0; m < 4; ++m) {
                    const int r = row0 + ai * HALF + m * 16; const float rstd = rs[ai][m];
                    bf16_t* rowp = gate + (size_t)r * 2048 + g0;
#pragma unroll
                    for (int bj = 0; bj < 2; ++bj) { f32x4 s[2];
#pragma unroll
                        for (int n = 0; n < 2; ++n) { const f32x4 v = acc[ai][bj][m][n] * rstd + bv[bj][n];
#pragma unroll
                            for (int i = 0; i < 4; ++i) s[n][i] = __builtin_amdgcn_rcpf(1.0f + __builtin_amdgcn_exp2f(v[i] * -1.4426950408889634f)); }
                        *(u32x4*)(rowp + bj * HALF) = pack8(s[0], s[1]); }
                }
        }
    }
};
struct EpiGateMerge {
    static constexpr bool PERM = true, AFTER_DRAIN = false;
    const bf16_t* gate; bf16_t* merged;
    __device__ __forceinline__ bool keep(const Unit& u) const { return u.z == 0; }
    __device__ __forceinline__ void operator()(f32x4 (&acc)[2][2][4][2], const Unit& u, int wr, int wc, int fr, int fq) const {
        const int row0 = u.pm * BM + wr * 64 + fr, col0 = u.pn * BM + wc * 32 + 8 * fq;
#pragma unroll
        for (int ai = 0; ai < 2; ++ai)
#pragma unroll
        for (int mh = 0; mh < 2; ++mh) {
            u32x4 g1v[2][2];
#pragma unroll
            for (int mm = 0; mm < 2; ++mm)
#pragma unroll
                for (int bj = 0; bj < 2; ++bj) g1v[mm][bj] = *(const u32x4*)(gate + (size_t)(row0 + ai * HALF + (2 * mh + mm) * 16) * 2048 + 1024 + col0 + bj * HALF);
#pragma unroll
            for (int mm = 0; mm < 2; ++mm)
#pragma unroll
                for (int bj = 0; bj < 2; ++bj) { const int m = 2 * mh + mm; const int r = row0 + ai * HALF + m * 16; const u32x4 g1 = g1v[mm][bj];
                    const f32x4 g1a = {bflo(g1.x), bfhi(g1.x), bflo(g1.y), bfhi(g1.y)}, g1b = {bflo(g1.z), bfhi(g1.z), bflo(g1.w), bfhi(g1.w)};
                    if (u.z == 0) {
                        const u32x4 g0 = *(const u32x4*)(gate + (size_t)r * 2048 + col0 + bj * HALF);
                        const f32x4 g0a = {bflo(g0.x), bfhi(g0.x), bflo(g0.y), bfhi(g0.y)}, g0b = {bflo(g0.z), bfhi(g0.z), bflo(g0.w), bfhi(g0.w)};
#pragma unroll
                        for (int i = 0; i < 4; ++i) { acc[ai][bj][m][0][i] *= g0a[i] * __builtin_amdgcn_rcpf(__builtin_fmaxf(g1a[i], 1e-30f)); acc[ai][bj][m][1][i] *= g0b[i] * __builtin_amdgcn_rcpf(__builtin_fmaxf(g1b[i], 1e-30f)); }
                    } else {
                        *(u32x4*)(merged + (size_t)r * 1024 + col0 + bj * HALF) = pack8(acc[ai][bj][m][0] * g1a, acc[ai][bj][m][1] * g1b); }
                }
        }
    }
};
struct EpiResid {
    static constexpr bool PERM = true, AFTER_DRAIN = false;
    float* xout; bf16_t* xb; float* pss; PG8_LAS float* red;
    __device__ __forceinline__ bool keep(const Unit&) const { return false; }
    __device__ __forceinline__ void operator()(f32x4 (&acc)[2][2][4][2], const Unit& u, int wr, int wc, int fr, int fq) const {
        const int row0 = u.pm * BM + wr * 64 + fr, col0 = u.pn * BM + wc * 32 + 8 * fq;
#pragma unroll
        for (int ai = 0; ai < 2; ++ai) {
            u32x4 xov[4][2];
#pragma unroll
            for (int m = 0; m < 4; ++m)
#pragma unroll
                for (int bj = 0; bj < 2; ++bj) xov[m][bj] = *(const u32x4*)(xb + (size_t)(row0 + ai * HALF + m * 16) * 1024 + col0 + bj * HALF);
#pragma unroll
            for (int m = 0; m < 4; ++m) {
                const int r = row0 + ai * HALF + m * 16; const size_t off = (size_t)r * 1024 + col0; float ss = 0.f;
#pragma unroll
                for (int bj = 0; bj < 2; ++bj) {
                    const u32x4 xo = xov[m][bj];
                    f32x4 xn[2]; xn[0] = (f32x4){bflo(xo.x), bfhi(xo.x), bflo(xo.y), bfhi(xo.y)} + acc[ai][bj][m][0]; xn[1] = (f32x4){bflo(xo.z), bfhi(xo.z), bflo(xo.w), bfhi(xo.w)} + acc[ai][bj][m][1];
#pragma unroll
                    for (int n = 0; n < 2; ++n) { const f32x4 q = xn[n] * xn[n]; ss += (q[0] + q[1]) + (q[2] + q[3]); if (xout) *(f32x4*)(xout + off + bj * HALF + 4 * n) = xn[n]; }
                    *(u32x4*)(xb + off + bj * HALF) = pack8(xn[0], xn[1]); }
                ss += __shfl_xor(ss, 16); ss += __shfl_xor(ss, 32);
                if (fq == 0) red[(ai * HALF + wr * 64 + m * 16 + fr) * 4 + wc] = ss;
            }
        }
        asm volatile("s_waitcnt lgkmcnt(0)" ::: "memory"); __builtin_amdgcn_s_barrier(); asm volatile("" ::: "memory");
        { const int t = (wr * 4 + wc) * 64 + fq * 16 + fr;
          if (t < BM) { const f32x4 p = *(const PG8_LAS f32x4*)(red + t * 4); pss[(size_t)u.pn * PSS_M + u.pm * BM + t] = (p[0] + p[1]) + (p[2] + p[3]); } }
    }
};
struct EpiSwiGLU {
    static constexpr bool PERM = true, AFTER_DRAIN = false;
    bf16_t* act; const float* pss;
    __device__ __forceinline__ bool keep(const Unit&) const { return false; }
    __device__ __forceinline__ void operator()(f32x4 (&acc)[2][2][4][2], const Unit& u, int wr, int wc, int fr, int fq) const {
        const int row0 = u.pm * BM + wr * 64 + fr, col0 = u.pn * 128 + wc * 32 + 8 * fq;
        float rs[2][4];
        rows_rstd8(pss, row0, fq, rs);
#pragma unroll
        for (int ai = 0; ai < 2; ++ai)
#pragma unroll
            for (int m = 0; m < 4; ++m) {
                const int r = row0 + ai * HALF + m * 16; const float rstd = rs[ai][m]; f32x4 a[2];
#pragma unroll
                for (int n = 0; n < 2; ++n) { const f32x4 g = acc[ai][0][m][n] * rstd, uu = acc[ai][1][m][n] * rstd;
#pragma unroll
                    for (int i = 0; i < 4; ++i) a[n][i] = g[i] * __builtin_amdgcn_rcpf(1.0f + __builtin_amdgcn_exp2f(g[i] * -1.4426950408889634f)) * uu[i]; }
                *(u32x4*)(act + (size_t)r * 2816 + col0) = pack8(a[0], a[1]);
            }
    }
};
struct ZOrder {
    StaticOrder S;
    __device__ __forceinline__ bool next(int i, Unit& u) const { if (!S.next(i >> 1, u)) return false; u.z = i & 1; return true; }
    __device__ __forceinline__ void a_ready(const Unit&) const {}
    __device__ __forceinline__ void done(const Unit&) const {}
};

template <class Epi, class Sched, bool ALIGN_EPI = false, bool SP2 = false>
__device__ __forceinline__ void gemm_phase(PG8_LAS unsigned char* lds, const Gemm g, const Sched& S, const Epi& E) {
    int tid = threadIdx.x; asm volatile("" : "+v"(tid));
    const int wid = __builtin_amdgcn_readfirstlane(tid >> 6), lane = tid & 63, wr = wid >> 2, wc = wid & 3, fr = lane & 15, fq = lane >> 4;
    const int K = g.K, nt = K / BK;
    unsigned voffA[2], voffB[2];
#pragma unroll
    for (int i = 0; i < 2; ++i) { int R, C; stage_rc(tid * 16 + i * 8192, R, C); const int Rb = Epi::PERM ? ((R & ~31) + perm32(R & 31)) : R;
        voffA[i] = (unsigned)(R * K + C) * 2u; voffB[i] = (unsigned)(Rb * K + C) * 2u; }
    const size_t kstep = (size_t)(BK * 2);
    const size_t hstep = (size_t)HALF * K * 2;
    const size_t tstep = 2 * hstep;
    const unsigned ldsw = (unsigned)wid * 1024u;
    const int aoff = lds_byte(wr * 64 + fr, fq * 8), boff = lds_byte(wc * 32 + fr, fq * 8);
#define PG8_SA(b, h) (((b) * 2 + (h)) * HTB)
#define PG8_SB(b, h) ((4 + (b) * 2 + (h)) * HTB)
#define PG8_STAGE(bufoff, gbase, voff) do { _Pragma("unroll") for (int _i = 0; _i < 2; ++_i) \
        __builtin_amdgcn_global_load_lds((const unsigned*)((const char*)(gbase) + (voff)[_i]), (PG8_LAS unsigned*)(lds + (bufoff) + ldsw + _i * 8192), 16, 0, 0); } while (0)
#define PG8_LDA(dst, b, h) do { _Pragma("unroll") for (int m = 0; m < 4; ++m) _Pragma("unroll") for (int k = 0; k < 2; ++k) dst[m][k] = *(const PG8_LAS bf16x8*)(lds + PG8_SA(b, h) + aoff + m * 2048 + k * 1024); } while (0)
#define PG8_LDB(dst, b, h) do { _Pragma("unroll") for (int n = 0; n < 2; ++n) _Pragma("unroll") for (int k = 0; k < 2; ++k) dst[n][k] = *(const PG8_LAS bf16x8*)(lds + PG8_SB(b, h) + boff + n * 2048 + k * 1024); } while (0)
#define PG8_MMA(ai, bj, At, Bt) do { __builtin_amdgcn_s_setprio(1); _Pragma("unroll") for (int m = 0; m < 4; ++m) _Pragma("unroll") for (int n = 0; n < 2; ++n) _Pragma("unroll") for (int k = 0; k < 2; ++k) \
        acc[ai][bj][m][n] = __builtin_amdgcn_mfma_f32_16x16x32_bf16(Bt[n][k], At[m][k], acc[ai][bj][m][n], 0, 0, 0); __builtin_amdgcn_s_setprio(0); } while (0)
#define PG8_WAIT_V(n) asm volatile("s_waitcnt vmcnt(" #n ")" ::: "memory")
#define PG8_WAIT_L(n) asm volatile("s_waitcnt lgkmcnt(" #n ")" ::: "memory")
#define PG8_BAR __builtin_amdgcn_s_barrier()
#define PG8_SCHED __builtin_amdgcn_sched_barrier(0)
    Unit cur, nxt; int ui = 0;
    if (!S.next(0, cur)) return;
    f32x4 acc[2][2][4][2];
#pragma unroll
    for (int a = 0; a < 2; ++a)
#pragma unroll
        for (int b = 0; b < 2; ++b)
#pragma unroll
            for (int m = 0; m < 4; ++m)
#pragma unroll
                for (int n = 0; n < 2; ++n) acc[a][b][m][n] = (f32x4){0.f, 0.f, 0.f, 0.f};
    bf16x8 At[4][2], B0[2][2], B1[2][2];
    const char* cA = (const char*)g.A + (size_t)cur.pm * tstep + (size_t)cur.z * g.zA; const char* cB = (const char*)g.Bt + (size_t)cur.pn * tstep + (size_t)cur.z * g.zB;
    S.a_ready(cur);
    if constexpr (SP2) {
        PG8_STAGE(PG8_SB(0, 0), cB, voffB); PG8_STAGE(PG8_SB(0, 1), cB + hstep, voffB); PG8_STAGE(PG8_SA(0, 0), cA, voffA); PG8_STAGE(PG8_SA(0, 1), cA + hstep, voffA);
        if (wr == 1) PG8_BAR;
        PG8_WAIT_V(2); PG8_BAR;
        PG8_STAGE(PG8_SB(1, 0), cB + kstep, voffB); PG8_STAGE(PG8_SA(1, 0), cA + kstep, voffA); PG8_STAGE(PG8_SB(1, 1), cB + hstep + kstep, voffB);
        PG8_WAIT_V(6); PG8_BAR;
    } else {
        PG8_STAGE(PG8_SB(0, 0), cB, voffB); PG8_STAGE(PG8_SA(0, 0), cA, voffA); PG8_STAGE(PG8_SB(0, 1), cB + hstep, voffB); PG8_STAGE(PG8_SA(0, 1), cA + hstep, voffA);
        if (wr == 1) PG8_BAR;
        PG8_WAIT_V(4); PG8_BAR;
        PG8_STAGE(PG8_SB(1, 0), cB + kstep, voffB); PG8_STAGE(PG8_SA(1, 0), cA + kstep, voffA); PG8_STAGE(PG8_SB(1, 1), cB + hstep + kstep, voffB);
        PG8_WAIT_V(6); PG8_BAR;
    }
    for (;;) {
        const bool has_next = S.next(ui + 1, nxt);
        const char* nA = has_next ? (const char*)g.A + (size_t)nxt.pm * tstep + (size_t)nxt.z * g.zA : cA; const char* nB = has_next ? (const char*)g.Bt + (size_t)nxt.pn * tstep + (size_t)nxt.z * g.zB : cB;
        for (int t = 0; t < nt; t += 2) {
            const bool last = (t == nt - 2);
            const char* a1 = cA + (size_t)(t + 1) * kstep;
            const char* a2 = last ? nA : cA + (size_t)(t + 2) * kstep; const char* b2 = last ? nB : cB + (size_t)(t + 2) * kstep;
            const char* a3 = a2 + kstep; const char* b3 = b2 + kstep;
            if (last && has_next) S.a_ready(nxt);
            if constexpr (SP2) {
            PG8_LDB(B0, 0, 0); PG8_LDB(B1, 0, 1); PG8_SCHED; PG8_LDA(At, 0, 0); PG8_STAGE(PG8_SA(1, 1), a1 + hstep, voffA);
            PG8_WAIT_V(8); PG8_WAIT_L(0); PG8_BAR; PG8_MMA(0, 0, At, B0); PG8_MMA(0, 1, At, B1); PG8_BAR; PG8_SCHED;
            PG8_LDA(At, 0, 1); PG8_STAGE(PG8_SB(0, 0), b2, voffB); PG8_STAGE(PG8_SB(0, 1), b2 + hstep, voffB); PG8_STAGE(PG8_SA(0, 0), a2, voffA);
            PG8_WAIT_V(8); PG8_WAIT_L(0); PG8_BAR; PG8_MMA(1, 0, At, B0); PG8_MMA(1, 1, At, B1); PG8_BAR; PG8_SCHED;
            PG8_LDB(B0, 1, 0); PG8_LDB(B1, 1, 1); PG8_SCHED; PG8_LDA(At, 1, 0); PG8_STAGE(PG8_SA(0, 1), a2 + hstep, voffA);
            PG8_WAIT_V(8); PG8_WAIT_L(0); PG8_BAR; PG8_MMA(0, 0, At, B0); PG8_MMA(0, 1, At, B1); PG8_BAR; PG8_SCHED;
            PG8_LDA(At, 1, 1); PG8_STAGE(PG8_SB(1, 0), b3, voffB); PG8_STAGE(PG8_SB(1, 1), b3 + hstep, voffB); PG8_STAGE(PG8_SA(1, 0), a3, voffA);
            PG8_WAIT_V(8); PG8_WAIT_L(0); PG8_BAR; PG8_MMA(1, 0, At, B0); PG8_MMA(1, 1, At, B1); PG8_BAR; PG8_SCHED;
            } else {
            PG8_LDB(B0, 0, 0); PG8_SCHED; PG8_LDA(At, 0, 0); PG8_STAGE(PG8_SA(1, 1), a1 + hstep, voffA);
            PG8_WAIT_L(8); PG8_BAR; PG8_WAIT_L(0); PG8_MMA(0, 0, At, B0); PG8_BAR; PG8_SCHED;
            PG8_LDB(B1, 0, 1); PG8_STAGE(PG8_SB(0, 0), b2, voffB);
            PG8_BAR; PG8_WAIT_L(0); PG8_MMA(0, 1, At, B1); PG8_BAR;
            PG8_LDA(At, 0, 1); PG8_STAGE(PG8_SA(0, 0), a2, voffA);
            PG8_BAR; PG8_WAIT_L(0); PG8_MMA(1, 0, At, B0); PG8_BAR; PG8_SCHED;
            PG8_STAGE(PG8_SB(0, 1), b2 + hstep, voffB);
            PG8_WAIT_V(6); PG8_BAR; PG8_MMA(1, 1, At, B1); PG8_BAR;
            PG8_LDB(B0, 1, 0); PG8_SCHED; PG8_LDA(At, 1, 0); PG8_STAGE(PG8_SA(0, 1), a2 + hstep, voffA);
            PG8_WAIT_L(8); PG8_BAR; PG8_WAIT_L(0); PG8_MMA(0, 0, At, B0); PG8_BAR; PG8_SCHED;
            PG8_LDB(B1, 1, 1); PG8_STAGE(PG8_SB(1, 0), b3, voffB);
            PG8_BAR; PG8_WAIT_L(0); PG8_MMA(0, 1, At, B1); PG8_BAR;
            PG8_LDA(At, 1, 1); PG8_STAGE(PG8_SA(1, 0), a3, voffA);
            PG8_BAR; PG8_WAIT_L(0); PG8_MMA(1, 0, At, B0); PG8_BAR; PG8_SCHED;
            PG8_STAGE(PG8_SB(1, 1), b3 + hstep, voffB);
            PG8_WAIT_V(6); PG8_BAR; PG8_MMA(1, 1, At, B1); PG8_BAR;
            }
        }
        if constexpr (ALIGN_EPI) { if (wr == 0) PG8_BAR; }
        if constexpr (!Epi::AFTER_DRAIN) { E(acc, cur, wr, wc, fr, fq); S.done(cur); }
        if (!has_next) break;
        if (!E.keep(cur)) {
#pragma unroll
        for (int a = 0; a < 2; ++a)
#pragma unroll
            for (int b = 0; b < 2; ++b)
#pragma unroll
                for (int m = 0; m < 4; ++m)
#pragma unroll
                    for (int n = 0; n < 2; ++n) acc[a][b][m][n] = (f32x4){0.f, 0.f, 0.f, 0.f};
        }
        cur = nxt; cA = nA; cB = nB; ++ui;
        if constexpr (ALIGN_EPI) { if (wr == 1) PG8_BAR; }
    }
    PG8_WAIT_V(0);
    if constexpr (!ALIGN_EPI) { if (wr == 0) PG8_BAR; }
    PG8_BAR;
    if constexpr (Epi::AFTER_DRAIN) { E.fused(acc, cur, wr, wc, fr, fq, lds, wid, lane); S.done(cur); }
#undef PG8_SA
#undef PG8_SB
#undef PG8_STAGE
#undef PG8_LDA
#undef PG8_LDB
#undef PG8_MMA
#undef PG8_WAIT_V
#undef PG8_WAIT_L
#undef PG8_BAR
#undef PG8_SCHED
}
}
#include <hip/hip_bf16.h>
#include <cmath>
namespace attn_body {
using bf16=__hip_bfloat16;
using bf16x8=__attribute__((ext_vector_type(8)))short;
using s16x4=__attribute__((ext_vector_type(4)))short;
using f32x16=__attribute__((ext_vector_type(16)))float;
using u32x4=__attribute__((ext_vector_type(4)))unsigned;
constexpr int SEQ=8192,D=64,PIN=2304,POUT=512;
constexpr int NW=8,QBLK=32,QB=QBLK*NW,KVBLK=64,NQB=SEQ/QB;
constexpr int ATTN_UNIT_ROWS=QB;
__device__ __forceinline__ int crow(int r,int hi){return (r&3)+8*(r>>2)+4*hi;}
#define SBAR() __builtin_amdgcn_sched_barrier(0)
__device__ __forceinline__ void gmask(f32x16&p0,f32x16&p1,int kvb,int qrel,int hi,bool WIN){
  const float NEG=-INFINITY; int kb=kvb+4*hi;
  #pragma unroll
  for(int r=0;r<16;++r){int kv=kb+(r&3)+8*(r>>2); if(kv>qrel)p0[r]=NEG; if(kv+32>qrel)p1[r]=NEG;
    if(WIN){ if(kv<=qrel-128)p0[r]=NEG; if(kv+32<=qrel-128)p1[r]=NEG; } }
}

constexpr int NSLOT=3, SLOTB=8192;
constexpr int LDS_K=0, LDS_V=NSLOT*SLOTB, LDS_WS=2*NSLOT*SLOTB, LDS_OST=LDS_WS+NW*64*4, LDS_BYTES=LDS_OST+NW*4096;
constexpr float C2=0.125f*1.4426950408889634f;
__device__ __forceinline__ void glds16(const void*gsrc,unsigned lds_dst){unsigned keep;
  asm volatile("s_mov_b32 %0, m0\n\ts_mov_b32 m0, %2\n\ts_nop 0\n\tglobal_load_lds_dwordx4 %1, off\n\ts_mov_b32 m0, %0":"=&s"(keep):"v"(gsrc),"s"(lds_dst):"memory");}
__device__ __forceinline__ float max3f(float a,float b,float c){float r;asm("v_max3_f32 %0, %1, %2, %3":"=v"(r):"v"(a),"v"(b),"v"(c));return r;}
__device__ __forceinline__ float max2f(float a,float b){float r;asm("v_max_f32_e32 %0, %1, %2":"=v"(r):"v"(a),"v"(b));return r;}
__device__ __forceinline__ float fadd_s(float a,float b){float r;asm("v_add_f32_e32 %0, %1, %2":"=v"(r):"v"(a),"v"(b));return r;}
__device__ __forceinline__ float fsub_s(float a,float b){float r;asm("v_sub_f32_e32 %0, %1, %2":"=v"(r):"v"(a),"v"(b));return r;}
typedef float f32x2_t __attribute__((ext_vector_type(2))); typedef __bf16 bf16x2_t __attribute__((ext_vector_type(2)));
__device__ __forceinline__ unsigned cvtpk_s(float lo,float hi){f32x2_t v={lo,hi};bf16x2_t b=__builtin_convertvector(v,bf16x2_t);return __builtin_bit_cast(unsigned,b);}
#define WAIT_BAR(N) asm volatile("s_waitcnt vmcnt(" #N ") lgkmcnt(0)\n\ts_barrier":::"memory")

__device__ __forceinline__ void qkt(f32x16&p0,f32x16&p1,const char*Kslot,const bf16x8*qr,int r32,int hi){
  const char*kb=Kslot+hi*1024+r32*16;
  #pragma unroll
  for(int d0=0;d0<4;++d0){
    const bf16x8 b0=*reinterpret_cast<const bf16x8*>(kb+d0*2048);
    const bf16x8 b1=*reinterpret_cast<const bf16x8*>(kb+d0*2048+512);
    p0=__builtin_amdgcn_mfma_f32_32x32x16_bf16(b0,qr[d0],p0,0,0,0);p1=__builtin_amdgcn_mfma_f32_32x32x16_bf16(b1,qr[d0],p1,0,0,0);}
}
typedef __attribute__((address_space(3))) const char* lds_cptr;
typedef short v4i16_t __attribute__((ext_vector_type(4)));
__device__ __forceinline__ void kload8(bf16x8*kf,lds_cptr kp){
  kf[0]=*(const __attribute__((address_space(3))) bf16x8*)(kp);      kf[1]=*(const __attribute__((address_space(3))) bf16x8*)(kp+512);
  kf[2]=*(const __attribute__((address_space(3))) bf16x8*)(kp+2048); kf[3]=*(const __attribute__((address_space(3))) bf16x8*)(kp+2560);
  kf[4]=*(const __attribute__((address_space(3))) bf16x8*)(kp+4096); kf[5]=*(const __attribute__((address_space(3))) bf16x8*)(kp+4608);
  kf[6]=*(const __attribute__((address_space(3))) bf16x8*)(kp+6144); kf[7]=*(const __attribute__((address_space(3))) bf16x8*)(kp+6656);
}
__device__ __forceinline__ void kload2(bf16x8*kf,lds_cptr kp,int j){ kf[2*j]=*(const __attribute__((address_space(3))) bf16x8*)(kp+j*2048); kf[2*j+1]=*(const __attribute__((address_space(3))) bf16x8*)(kp+j*2048+512); }
__device__ __forceinline__ s16x4 vtr(lds_cptr p){ return __builtin_bit_cast(s16x4,__builtin_amdgcn_ds_read_tr16_b64_v4i16((__attribute__((address_space(3))) v4i16_t*)p)); }
__device__ __forceinline__ float rowmax(const f32x16&p0,const f32x16&p1){
  float a=max3f(p0[0],p0[1],p1[0]),b=max3f(p0[2],p0[3],p1[1]);a=max3f(a,p1[2],p1[3]);
  #pragma unroll
  for(int r=4;r<16;r+=4){a=max3f(a,p0[r],p0[r+1]);b=max3f(b,p0[r+2],p0[r+3]);a=max3f(a,p1[r],p1[r+1]);b=max3f(b,p1[r+2],p1[r+3]);}
  const float m=max2f(a,b);
  auto rr=__builtin_amdgcn_permlane32_swap(__float_as_uint(m),__float_as_uint(m),false,false);
  return max2f(__uint_as_float(rr[0]),__uint_as_float(rr[1]));
}
__device__ __forceinline__ void pv(f32x16*o,int vb,bf16x8 pa0,bf16x8 pa1,bf16x8 pa2,bf16x8 pa3){
  #pragma unroll
  for(int d0=0;d0<2;++d0){s16x4 lo[4],hi[4];
    #pragma unroll
    for(int ks=0;ks<4;++ks){
      asm volatile("ds_read_b64_tr_b16 %0,%1 offset:%c2":"=&v"(lo[ks]):"v"(vb),"i"(d0*4096+ks*1024):"memory");
      asm volatile("ds_read_b64_tr_b16 %0,%1 offset:%c2":"=&v"(hi[ks]):"v"(vb),"i"(d0*4096+ks*1024+512):"memory");}
    asm volatile("s_waitcnt lgkmcnt(0)":::"memory");SBAR();
    #define PK(k) (bf16x8){lo[k][0],lo[k][1],lo[k][2],lo[k][3],hi[k][0],hi[k][1],hi[k][2],hi[k][3]}
    o[d0]=__builtin_amdgcn_mfma_f32_32x32x16_bf16(pa0,PK(0),o[d0],0,0,0);
    o[d0]=__builtin_amdgcn_mfma_f32_32x32x16_bf16(pa1,PK(1),o[d0],0,0,0);
    o[d0]=__builtin_amdgcn_mfma_f32_32x32x16_bf16(pa2,PK(2),o[d0],0,0,0);
    o[d0]=__builtin_amdgcn_mfma_f32_32x32x16_bf16(pa3,PK(3),o[d0],0,0,0);
    #undef PK
  }
}

#ifndef ATTN_STORE16
#define ATTN_STORE16(p,v) (*(u32x4*)(p)=(v))
#endif
__device__ __forceinline__ void unit_qk_offsets(int vv,int ii,long&qo,long&ko){
  int q_,t_,qc_,kc_; long rb;
  if(ii<8){ const int s=vv&7,bhv=(vv>>3)+32*(ii>>2),i4=ii&3,b=bhv>>4,h=(bhv>>2)&3,c=(bhv>>1)&1;
    q_=(i4==0)?s:(i4==1)?15-s:(i4==2)?16+s:31-s; t_=0; rb=(long)b*SEQ; qc_=768+h*128+c*64; kc_=1280+h*128+c*64; }
  else{ const int ui=vv*4+(ii-8),hq=(ui>>5)&7,b=ui>>8; q_=ui&31; t_=q_>0?4*q_-2:0; rb=(long)b*SEQ; qc_=hq*64; kc_=512+(hq>>2)*64; }
  qo=qc_+(rb+(long)q_*QB)*PIN; ko=kc_+(rb+(long)t_*KVBLK)*PIN;
}
template<int THRL> __device__ __forceinline__ void attn_unit(long rowbase,int qb,int t0,bool WIN,bool NOMAX,const bf16*Qc,const bf16*__restrict__ Kc,const bf16*__restrict__ Vc,bf16*Oc,float s2,float sink2,char*shm,
    bf16x8 (&qr)[4],bool pref,const bf16*qkvb,int vn,int in_){
  int tid=threadIdx.x; asm volatile("":"+v"(tid)); const int lane=tid&63,r32=lane&31,hi=lane>>5; const int wid=__builtin_amdgcn_readfirstlane(tid>>6);
  const int q0=qb*QB;
  const bf16*Qw=Qc+(rowbase+q0+wid*QBLK)*PIN;
  const bf16*Kh=Kc+(rowbase+(long)t0*KVBLK)*PIN,*Vh=Vc+(rowbase+(long)t0*KVBLK)*PIN;
  const unsigned lds0=(unsigned)(uintptr_t)shm;
  float*wsf=(float*)(shm+LDS_WS)+wid*64;
  const bf16*ksrc=Kh+(long)lane*PIN+wid*8;
  const bf16*vsrc=Vh+(long)(16*(wid&3)+(lane>>2))*PIN+(wid>>2)*32+(lane&3)*8;
  const unsigned kdst=lds0+LDS_K+wid*1024, vdst=lds0+LDS_V+wid*1024;
  #define DMA_K(t,slot) glds16(ksrc+(long)(t)*KVBLK*PIN,(unsigned)__builtin_amdgcn_readfirstlane(kdst+(slot)))
  #define DMA_V(t,slot) glds16(vsrc+(long)(t)*KVBLK*PIN,(unsigned)__builtin_amdgcn_readfirstlane(vdst+(slot)))
  const int vb0=(int)(lds0+LDS_V)+((lane>>4)&1)*32+(lane&3)*8+(4*hi+((lane&15)>>2))*64;
  const char*Kbase=shm+LDS_K; bf16x8 kf[8];
  const lds_cptr shm3=(lds_cptr)shm; const lds_cptr kp0=shm3+LDS_K+hi*1024+r32*16; const lds_cptr vp0=shm3+LDS_V+((lane>>4)&1)*32+(lane&3)*8+(4*hi+((lane&15)>>2))*64;
  const int NT=(q0+QB)/KVBLK-t0;
  if(!pref){ DMA_K(0,0);DMA_V(0,0);DMA_K(1,SLOTB);
    _Pragma("unroll") for(int d0=0;d0<4;++d0)qr[d0]=*reinterpret_cast<const bf16x8*>(&Qw[(long)r32*PIN+d0*16+hi*8]);
  } else { DMA_V(0,0); }
  float mhat=0.f,l_reg=0.f;f32x16 o[2];o[0]=f32x16{};o[1]=f32x16{};
  const int qrel=q0-t0*KVBLK+wid*QBLK+r32;
  const float qb2=s2*(float)(qrel-4*hi);
  #define CINIT(C0,C1,btl) do{ const float b_=(btl); _Pragma("unroll") for(int r=0;r<16;++r){ C0[r]=__builtin_fmaf(s2,(float)((r&3)+8*(r>>2)),b_); C1[r]=__builtin_fmaf(s2,(float)((r&3)+8*(r>>2)+32),b_);} }while(0)
  #define CMASK(P0,P1,t) do{ if(WIN||(t)>=NT-4)gmask(P0,P1,64*(t),qrel,hi,WIN);}while(0)
  bool resc=false;
  #define START(P0,P1) do{ resc=false; \
    if(!NOMAX){ const float rm=rowmax(P0,P1); const float dl=__builtin_fmaxf(rm,0.f);     \
      mhat=fadd_s(mhat,dl); \
      _Pragma("unroll") for(int r=0;r<16;++r){P0[r]=fsub_s(P0[r],dl);P1[r]=fsub_s(P1[r],dl);} } \
    _Pragma("unroll") for(int r=0;r<16;++r)P0[r]=__builtin_amdgcn_exp2f(P0[r]); }while(0)
  #define RESC() do{ if(resc){ asm volatile("s_waitcnt lgkmcnt(0)":::"memory"); \
      _Pragma("unroll") for(int d_=0;d_<2;++d_) _Pragma("unroll") for(int r=0;r<16;++r)o[d_][r]*=wsf[crow(r,hi)]; } }while(0)
  f32x16 pA0,pA1,pB0,pB1;
  int sl_prev=0,sl_cur=0,sl_next=SLOTB;
  #define ROT() do{sl_prev=sl_cur;sl_cur=sl_next;sl_next=(sl_next==(NSLOT-1)*SLOTB)?0:sl_next+SLOTB;}while(0)
  if(!pref){ DMA_K(2,2*SLOTB);
    WAIT_BAR(3); }
  else { WAIT_BAR(5); }
  CINIT(pA0,pA1,-qb2); qkt(pA0,pA1,Kbase,qr,r32,hi);asm volatile("s_nop 15\n\ts_nop 7":"+v"(pA0),"+v"(pA1));CMASK(pA0,pA1,0);
  START(pA0,pA1);
  _Pragma("unroll") for(int r=0;r<16;++r)pA1[r]=__builtin_amdgcn_exp2f(pA1[r]);
  WAIT_BAR(0);
  DMA_K(3,0);DMA_V(1,SLOTB);
  ROT();
  kload8(kf,kp0+sl_cur);
  CINIT(pB0,pB1,__builtin_fmaf(s2,64.f,-qb2)-mhat); asm volatile("":"+v"(pB0)); asm volatile("":"+v"(pB1));
  WAIT_BAR(2);
  s16x4 vlo[8],vhi[8]; u32x4 pw0,pw1,pw2,pw3;
  #define PKW(P,B) cvtpk_s(P[B],P[B+1])
  #define PAF(k) __builtin_bit_cast(bf16x8,pw##k)
  #define VFR(i) (bf16x8){vlo[i][0],vlo[i][1],vlo[i][2],vlo[i][3],vhi[i][0],vhi[i][1],vhi[i][2],vhi[i][3]}
  #define PIN(x) asm volatile("":"+v"(x))
  #define MX3(a,b,c) __builtin_fmaxf(__builtin_fmaxf((a),(b)),(c))
  #define GAPA(MF,A0,A1,A2,A3,W0,W1,PW) do{ MF; sacc+=A0; sacc+=A1; sacc+=A2; sacc+=A3; PIN(sacc); W0; W1; PIN(PW); SBAR(); }while(0)
  #define EX(v) __builtin_amdgcn_exp2f(v)
  #define GAPB(MF,X,B) do{ MF; X[B]=EX(X[B]); X[B+1]=EX(X[B+1]); X[B+2]=EX(X[B+2]); X[B+3]=EX(X[B+3]); PIN(X); SBAR(); }while(0)
  #define VRD(i) do{ vlo[i]=vtr(vp_+(((i)>>2)*4096+((i)&3)*1024)); vhi[i]=vtr(vp_+(((i)>>2)*4096+((i)&3)*1024+512)); }while(0)
  #define KRD(G,j) do{ if(G){ kload2(kf,kp0+sl_next,j); SBAR(); } }while(0)
  #define STEP(C0,C1,P0,P1,t,GK,GV,GL) do{ SBAR();     \
    const lds_cptr vp_=vp0+sl_prev; \
    VRD(0); SBAR(); float sacc=(P0[0]+P0[1]); \
    GAPA(C0=__builtin_amdgcn_mfma_f32_32x32x16_bf16(kf[0],qr[0],C0,0,0,0), P0[2],P0[3],P0[4],P0[5],     pw0[0]=PKW(P0,0), pw0[1]=PKW(P0,2), pw0); \
    VRD(4); SBAR(); GAPA(C1=__builtin_amdgcn_mfma_f32_32x32x16_bf16(kf[1],qr[0],C1,0,0,0), P0[6],P0[7],P0[8],P0[9],     pw0[2]=PKW(P0,4), pw0[3]=PKW(P0,6), pw0); \
    VRD(1); SBAR(); GAPA(C0=__builtin_amdgcn_mfma_f32_32x32x16_bf16(kf[2],qr[1],C0,0,0,0),   P0[10],P0[11],P0[12],P0[13], pw1[0]=PKW(P0,8), pw1[1]=PKW(P0,10), pw1); \
    VRD(5); SBAR(); GAPA(C1=__builtin_amdgcn_mfma_f32_32x32x16_bf16(kf[3],qr[1],C1,0,0,0),   P0[14],P0[15],P1[0],P1[1],   pw1[2]=PKW(P0,12),pw1[3]=PKW(P0,14), pw1); \
    VRD(2); SBAR(); GAPA(C0=__builtin_amdgcn_mfma_f32_32x32x16_bf16(kf[4],qr[2],C0,0,0,0),   P1[2],P1[3],P1[4],P1[5],     pw2[0]=PKW(P1,0), pw2[1]=PKW(P1,2), pw2); \
    VRD(6); SBAR(); GAPA(C1=__builtin_amdgcn_mfma_f32_32x32x16_bf16(kf[5],qr[2],C1,0,0,0),   P1[6],P1[7],P1[8],P1[9],     pw2[2]=PKW(P1,4), pw2[3]=PKW(P1,6), pw2); \
    VRD(3); SBAR(); GAPA(C0=__builtin_amdgcn_mfma_f32_32x32x16_bf16(kf[6],qr[3],C0,0,0,0),   P1[10],P1[11],P1[12],P1[13], pw3[0]=PKW(P1,8), pw3[1]=PKW(P1,10), pw3); \
    VRD(7); SBAR(); GAPA(C1=__builtin_amdgcn_mfma_f32_32x32x16_bf16(kf[7],qr[3],C1,0,0,0),   P1[14],P1[15],0.f,0.f,       pw3[2]=PKW(P1,12),pw3[3]=PKW(P1,14), pw3); \
    l_reg+=sacc; \
    if(GK){DMA_K((t)+3,sl_cur);} if(GV){DMA_V((t)+1,sl_next);} \
    CMASK(C0,C1,t); \
    if(!NOMAX){ float a=MX3(C0[0],C0[1],C1[0]),b=MX3(C0[2],C0[3],C1[1]); a=MX3(a,C1[2],C1[3]); \
      _Pragma("unroll") for(int r=4;r<16;r+=4){a=MX3(a,C0[r],C0[r+1]);b=MX3(b,C0[r+2],C0[r+3]);a=MX3(a,C1[r],C1[r+1]);b=MX3(b,C1[r+2],C1[r+3]);} \
      float rm=__builtin_fmaxf(a,b); { auto rr=__builtin_amdgcn_permlane32_swap(__float_as_uint(rm),__float_as_uint(rm),false,false); rm=__builtin_fmaxf(__uint_as_float(rr[0]),__uint_as_float(rr[1])); } \
      resc=false; \
      if(__builtin_expect(__any(rm>(float)THRL),0)){ const float dl=__builtin_fmaxf(rm,0.f); mhat+=dl; \
        _Pragma("unroll") for(int r=0;r<16;++r){C0[r]-=dl;C1[r]-=dl;} \
        const float f=__builtin_amdgcn_exp2f(-dl); l_reg*=f; if(hi==0)wsf[r32]=f; resc=true; } } else resc=false; \
    SBAR(); \
    GAPB(o[0]=__builtin_amdgcn_mfma_f32_32x32x16_bf16(PAF(0),VFR(0),o[0],0,0,0), C0,0); \
    GAPB(o[1]=__builtin_amdgcn_mfma_f32_32x32x16_bf16(PAF(0),VFR(4),o[1],0,0,0), C0,4); \
    KRD(GL,0); GAPB(o[0]=__builtin_amdgcn_mfma_f32_32x32x16_bf16(PAF(1),VFR(1),o[0],0,0,0), C0,8); \
    KRD(GL,1); GAPB(o[1]=__builtin_amdgcn_mfma_f32_32x32x16_bf16(PAF(1),VFR(5),o[1],0,0,0), C0,12); \
    KRD(GL,2); GAPB(o[0]=__builtin_amdgcn_mfma_f32_32x32x16_bf16(PAF(2),VFR(2),o[0],0,0,0), C1,0); \
    KRD(GL,3); GAPB(o[1]=__builtin_amdgcn_mfma_f32_32x32x16_bf16(PAF(2),VFR(6),o[1],0,0,0), C1,4); \
    GAPB(o[0]=__builtin_amdgcn_mfma_f32_32x32x16_bf16(PAF(3),VFR(3),o[0],0,0,0), C1,8); \
    GAPB(o[1]=__builtin_amdgcn_mfma_f32_32x32x16_bf16(PAF(3),VFR(7),o[1],0,0,0), C1,12); \
    CINIT(P0,P1,__builtin_fmaf(s2,(float)(64*((t)+1)),-qb2)-mhat); PIN(P0); PIN(P1);     \
    }while(0)
  int t=1;
  #undef CMASK
  #define CMASK(P0,P1,t) do{}while(0)
  for(;t+5<NT;t+=2){
    STEP(pB0,pB1,pA0,pA1,t,true,true,true);     WAIT_BAR(2); RESC(); ROT();
    STEP(pA0,pA1,pB0,pB1,t+1,true,true,true);   WAIT_BAR(2); RESC(); ROT();
  }
  #undef CMASK
  #define CMASK(P0,P1,t) do{ if(WIN||(t)>=NT-4)gmask(P0,P1,64*(t),qrel,hi,WIN);}while(0)
  #define ENDW(tt) do{ if((tt)+3<NT){WAIT_BAR(2);} else if((tt)+2<NT){WAIT_BAR(1);} else {WAIT_BAR(0);} }while(0)
  for(;t+1<NT;t+=2){
    STEP(pB0,pB1,pA0,pA1,t,(t+3<NT),(t+1<NT),(t+1<NT));       ENDW(t);   RESC(); ROT();
    STEP(pA0,pA1,pB0,pB1,t+1,(t+4<NT),(t+2<NT),(t+2<NT));     ENDW(t+1); RESC(); ROT();
  }
  STEP(pB0,pB1,pA0,pA1,NT-1,false,false,false); RESC();
  if(in_>=0){ long qo,ko; unit_qk_offsets(vn,in_,qo,ko);
    const bf16*ksn=qkvb+ko+(long)lane*PIN+wid*8;
    glds16(ksn,(unsigned)__builtin_amdgcn_readfirstlane(kdst)); glds16(ksn+(long)KVBLK*PIN,(unsigned)__builtin_amdgcn_readfirstlane(kdst+SLOTB)); glds16(ksn+(long)2*KVBLK*PIN,(unsigned)__builtin_amdgcn_readfirstlane(kdst+2*SLOTB));
    const bf16*Qwn=qkvb+qo+(long)(wid*QBLK)*PIN;
    _Pragma("unroll") for(int d0=0;d0<4;++d0)qr[d0]=*reinterpret_cast<const bf16x8*>(&Qwn[(long)r32*PIN+d0*16+hi*8]); }
  { float sacc=pB0[0]+pB0[1]; _Pragma("unroll") for(int r=2;r<16;++r)sacc+=pB0[r]; _Pragma("unroll") for(int r=0;r<16;++r)sacc+=pB1[r]; l_reg+=sacc;
    pw0=(u32x4){PKW(pB0,0),PKW(pB0,2),PKW(pB0,4),PKW(pB0,6)};pw1=(u32x4){PKW(pB0,8),PKW(pB0,10),PKW(pB0,12),PKW(pB0,14)};pw2=(u32x4){PKW(pB1,0),PKW(pB1,2),PKW(pB1,4),PKW(pB1,6)};pw3=(u32x4){PKW(pB1,8),PKW(pB1,10),PKW(pB1,12),PKW(pB1,14)};
    SBAR(); pv(o,vb0+sl_cur,PAF(0),PAF(1),PAF(2),PAF(3)); }
  #undef PKW
  #undef PAF
  #undef VFR
  #undef PIN
  #undef MX3
  #undef GAPA
  #undef GAPB
  #undef EX
  #undef VRD
  #undef KRD
  #undef STEP
  #undef ENDW
  {auto rr=__builtin_amdgcn_permlane32_swap(__float_as_uint(l_reg),__float_as_uint(l_reg),false,false);l_reg=__uint_as_float(rr[0])+__uint_as_float(rr[1]);}
  l_reg+=__builtin_amdgcn_exp2f(sink2-mhat);
  if(hi==0)wsf[32+r32]=l_reg;asm volatile("s_waitcnt lgkmcnt(0)":::"memory");
  float rli[16];
  #pragma unroll
  for(int r=0;r<16;++r)rli[r]=__builtin_amdgcn_rcpf(wsf[32+crow(r,hi)]);
  bf16*Ow=Oc+(rowbase+q0+wid*QBLK)*POUT;
  { bf16*stg=(bf16*)(shm+LDS_OST)+wid*2048;
    #pragma unroll
    for(int r=0;r<16;++r){const int orow=crow(r,hi);
      #pragma unroll
      for(int d0=0;d0<2;++d0)stg[orow*64+d0*32+r32]=__float2bfloat16(o[d0][r]*rli[r]);}
    asm volatile("s_waitcnt lgkmcnt(0)":::"memory");
    #pragma unroll
    for(int i=0;i<4;++i){const int row=i*8+(lane>>3),ch=lane&7; const u32x4 v=*(const u32x4*)(stg+row*64+ch*8); ATTN_STORE16(Ow+(long)row*POUT+ch*8,v);} }
  asm volatile("s_waitcnt lgkmcnt(0)\n\ts_barrier":::"memory");
  #undef DMA_K
  #undef DMA_V
  #undef CMASK
  #undef START
  #undef RESC
  #undef ROT
  #undef CINIT
}
constexpr int ATTN_LDS_BYTES=LDS_BYTES;
#undef SBAR
#undef WAIT_BAR
}
constexpr int NWAVES = 8;
constexpr int BATCH = 4, SEQ = 8192, DM = 1024, DEPTH = 4, M = BATCH * SEQ;
constexpr int INC = 4352, FFH = 2816, NQKV = 2304, NGATE = 2048;
constexpr size_t MiB = 1u << 20;
constexpr size_t WS_WIN = 0, WS_WB = 9 * MiB, WS_WO = 11 * MiB, WS_W1 = 13 * MiB, WS_W2 = 24 * MiB;
constexpr size_t WS_PSS = 30 * MiB;
constexpr size_t WS_QKV = 32 * MiB;
constexpr size_t WS_GATE = 176 * MiB;
constexpr size_t WS_ACT = 32 * MiB;
constexpr size_t WS_OA = 304 * MiB, WS_OB = 336 * MiB;
constexpr size_t WS_XB = 434 * MiB;
constexpr size_t WS_OD0 = 368 * MiB, WS_OD1 = 400 * MiB;
constexpr size_t WS_MRG = 368 * MiB;
constexpr size_t WS_END = 432 * MiB;
static_assert((DEPTH & 1) == 0 && WS_WIN + (size_t)INC * DM * 2 <= WS_WB && WS_W1 + (size_t)2 * FFH * DM * 2 <= WS_W2 && WS_W2 + (size_t)DM * FFH * 2 <= WS_PSS && WS_QKV + (size_t)M * NQKV * 2 <= WS_GATE && WS_GATE + (size_t)M * NGATE * 2 <= WS_OA && WS_ACT + (size_t)M * FFH * 2 <= WS_OA, "ws map");
constexpr int RING_BYTES = 131072, LDS_BYTES = 147456;
#define GAS __attribute__((address_space(1)))
#define LAS __attribute__((address_space(3)))
typedef unsigned short bf16;
typedef unsigned v4u __attribute__((ext_vector_type(4)));
typedef float f32x4 __attribute__((ext_vector_type(4)));
#define LDS_WAIT() asm volatile("s_waitcnt lgkmcnt(0)" ::: "memory")
__device__ __forceinline__ unsigned f2bf(float f) { unsigned u = __builtin_bit_cast(unsigned, f); return (u + 0x7fffu + ((u >> 16) & 1u)) >> 16; }
__device__ __forceinline__ unsigned pk2(float lo, float hi) { return f2bf(lo) | (f2bf(hi) << 16); }
__device__ __forceinline__ float wave_sum(float v) {
#pragma unroll
    for (int o = 1; o < 64; o <<= 1) v += __shfl_xor(v, o);
    return v;
}
__device__ __forceinline__ void transpose_item(const float* W, int ldw, const float* gain, bf16* WT, int K, int dst_row0, int k0, int n0, LAS float* scr, int lane) {
    float v[32];
#pragma unroll
    for (int i = 0; i < 32; ++i) { const int kk = 2 * i + (lane >> 5); v[i] = W[(size_t)(k0 + kk) * ldw + n0 + (lane & 31)]; }
    if (gain) {
#pragma unroll
        for (int i = 0; i < 32; ++i) v[i] *= gain[k0 + 2 * i + (lane >> 5)]; }
#pragma unroll
    for (int i = 0; i < 32; ++i) scr[(2 * i + (lane >> 5)) * 33 + (lane & 31)] = v[i];
    LDS_WAIT(); asm volatile("" ::: "memory");
    const int c = lane & 7;
#pragma unroll
    for (int j = 0; j < 4; ++j) { const int n = (lane >> 3) + 8 * j; const LAS float* s = scr + (8 * c) * 33 + n;
        v4u o; o.x = pk2(s[0 * 33], s[1 * 33]); o.y = pk2(s[2 * 33], s[3 * 33]); o.z = pk2(s[4 * 33], s[5 * 33]); o.w = pk2(s[6 * 33], s[7 * 33]);
        *(GAS v4u*)(WT + (size_t)(dst_row0 + n) * K + k0 + 8 * c) = o; }
    LDS_WAIT(); asm volatile("" ::: "memory");
}
#define RLX_AGENT __ATOMIC_RELAXED, __HIP_MEMORY_SCOPE_AGENT
#define XB_TMO      128
#define XB_XCNT(j)  (256  + 64 * (j))
#define XB_XSUB(j)  (1280 + 64 * (j))
#define XB_XGEN(j)  (2304 + 64 * (j))
#define XB_TOP      3328
#define XB_TOPGEN   3392
#define XCD_BAR_WORDS 3456
#define XB_SPIN_CAP (1u << 18)

__device__ __forceinline__ unsigned xb_ld(unsigned* p)              { return __hip_atomic_load(p, __ATOMIC_RELAXED, __HIP_MEMORY_SCOPE_AGENT); }
__device__ __forceinline__ unsigned xb_add(unsigned* p, unsigned v) { return __hip_atomic_fetch_add(p, v, __ATOMIC_RELAXED, __HIP_MEMORY_SCOPE_AGENT); }
__device__ __forceinline__ unsigned xb_xcc_id() { return (unsigned)__builtin_amdgcn_s_getreg((3 << 11) | 20) & 0xFu; }
#define XB_SPIN(cond, bar) do { unsigned _sp = 0; while (cond) { __builtin_amdgcn_s_sleep(1); \
    if ((++_sp & 255u) == 0u) { if (xb_ld(&(bar)[XB_TMO])) break; if (_sp > XB_SPIN_CAP) { atomicAdd(&(bar)[XB_TMO], 1u); break; } } } } while (0)

struct XcdBarrier {
    unsigned* bar; unsigned x;
    volatile LAS unsigned* st;
};

__device__ __forceinline__ XcdBarrier xcd_barrier_post(unsigned* bar, volatile LAS unsigned* st) {
    XcdBarrier b; b.bar = bar; b.x = xb_xcc_id(); b.st = st;
    if (threadIdx.x == 0) (void)xb_add(&bar[XB_XCNT(b.x)], 1u);
    return b;
}
__device__ __forceinline__ void xcd_barrier_complete(unsigned* bar, unsigned x, unsigned& nloc, unsigned& nx) {
    const unsigned G = gridDim.x * gridDim.y * gridDim.z;
    unsigned sum, cnt, mine, sp = 0u;
    for (;;) {
        sum = 0u; cnt = 0u; mine = 0u;
#pragma unroll
        for (unsigned j = 0; j < 16; ++j) { const unsigned c = xb_ld(&bar[XB_XCNT(j)]); sum += c; cnt += (c > 0u) ? 1u : 0u; mine = (j == x) ? c : mine; }
        if (sum == G) break;
        __builtin_amdgcn_s_sleep(1);
        if ((++sp & 255u) == 0u) { if (xb_ld(&bar[XB_TMO])) break; if (sp > XB_SPIN_CAP) { atomicAdd(&bar[XB_TMO], 1u); break; } }
    }
    nloc = mine > 0u ? mine : 1u; nx = cnt > 0u ? cnt : 1u;
}

__device__ __forceinline__ void xcd_barrier(const XcdBarrier& b) {
    asm volatile("s_waitcnt vmcnt(0)" ::: "memory");
    __syncthreads();
    if (threadIdx.x == 0) {
        unsigned* bar = b.bar;
        __builtin_amdgcn_s_waitcnt(0);
        unsigned nloc = b.st[0], nx = b.st[1];
        if (nloc == 0u) { xcd_barrier_complete(bar, b.x, nloc, nx); b.st[0] = nloc; b.st[1] = nx; }
        const unsigned old = xb_add(&bar[XB_XSUB(b.x)], 1u);
        const unsigned gen = old / nloc;
        if (old + 1u == (gen + 1u) * nloc) {
            __builtin_amdgcn_fence(__ATOMIC_RELEASE, "agent");
            asm volatile("s_waitcnt vmcnt(0)" ::: "memory");
            const unsigned og = xb_add(&bar[XB_TOP], 1u);
            const unsigned tg = og / nx;
            if (og + 1u == (tg + 1u) * nx) xb_add(&bar[XB_TOPGEN], 1u);
            else XB_SPIN(xb_ld(&bar[XB_TOPGEN]) == tg, bar);
            __builtin_amdgcn_fence(__ATOMIC_ACQUIRE, "agent");
            xb_add(&bar[XB_XGEN(b.x)], 1u);
            asm volatile("s_waitcnt vmcnt(0)" ::: "memory");
        } else {
            XB_SPIN(xb_ld(&bar[XB_XGEN(b.x)]) == gen, bar);
            __builtin_amdgcn_fence(__ATOMIC_ACQUIRE, "agent");
            asm volatile("s_waitcnt vmcnt(0)" ::: "memory");
        }
    }
    __syncthreads();
}

constexpr size_t WS_CTL = WS_END, CTL_ZERO_BYTES = 65536;
constexpr int CW_BAR = 1024;
constexpr int MISC_OFF = RING_BYTES + 320;
struct Args { const float* in[14]; float* out; unsigned char* ws; };

typedef const __attribute__((address_space(4))) Args* kargs_t;
#define WBASE(l) (((l) & 1) ? ap->ws : (unsigned char*)ap->out)
#define WB(l, off) ((bf16*)(WBASE(l) + (off)))
__device__ __forceinline__ void convert_weights(kargs_t ap, int lw, LAS float* scr, int lane, int it0, int stride) {
    const int l = lw; unsigned char* wb = WBASE(lw);
    bf16* WINt = (bf16*)(wb + WS_WIN); bf16* WBt = (bf16*)(wb + WS_WB); bf16* WOt = (bf16*)(wb + WS_WO); bf16* W1t = (bf16*)(wb + WS_W1); bf16* W2t = (bf16*)(wb + WS_W2);
    const float* w_in = ap->in[1] + (size_t)l * DM * INC; const float* w_br = ap->in[3] + (size_t)l * 2 * 512 * DM; const float* w_o = ap->in[4] + (size_t)l * DM * DM;
    const float* w_1 = ap->in[12] + (size_t)l * DM * 2 * FFH; const float* w_2 = ap->in[13] + (size_t)l * FFH * DM;
    const float* g_mix = ap->in[5] + l * DM; const float* g_ffn = ap->in[6] + l * DM;
            constexpr int I_IN = (DM / 64) * (INC / 32), I_BR = (512 / 64) * (DM / 32), I_O = (DM / 64) * (DM / 32), I_1 = (DM / 64) * (2 * FFH / 32), I_2 = (FFH / 64) * (DM / 32);
    constexpr int NITEMS = I_IN + 2 * I_BR + I_O + I_1 + I_2;
    for (int it = it0; it < NITEMS; it += stride) {
        int r = it;
        if (r < I_IN) { const int nblk = INC / 32, kb = r / nblk, nb = r % nblk, n0 = 32 * nb; int dst = n0;
            if (n0 < 2304) { const int pn = n0 >> 8, lb = (n0 & 255) >> 5; dst = 256 * pn + 128 * (lb & 1) + 32 * (lb >> 1); }
            transpose_item(w_in, INC, g_mix, WINt, DM, dst, 64 * kb, n0, scr, lane); continue; } r -= I_IN;
        if (r < 2 * I_BR) { const int z = r / I_BR; r -= z * I_BR; const int nblk = DM / 32, kb = r / nblk, nb = r % nblk;
            transpose_item(w_br + (size_t)z * 512 * DM, DM, nullptr, WBt + (size_t)z * DM * 512, 512, 32 * nb, 64 * kb, 32 * nb, scr, lane); continue; } r -= 2 * I_BR;
        if (r < I_O) { const int nblk = DM / 32, kb = r / nblk, nb = r % nblk; transpose_item(w_o, DM, nullptr, WOt, DM, 32 * nb, 64 * kb, 32 * nb, scr, lane); continue; } r -= I_O;
        if (r < I_1) { const int nblk = 2 * FFH / 32, kb = r / nblk, nb = r % nblk, n0 = 32 * nb; int dst;
            if (n0 < FFH) dst = 256 * (n0 >> 7) + (n0 & 127); else { const int n1 = n0 - FFH; dst = 256 * (n1 >> 7) + 128 + (n1 & 127); }
            transpose_item(w_1, 2 * FFH, g_ffn, W1t, DM, dst, 64 * kb, n0, scr, lane); continue; } r -= I_1;
        { const int nblk = DM / 32, kb = r / nblk, nb = r % nblk; transpose_item(w_2, DM, nullptr, W2t, FFH, 32 * nb, 64 * kb, 32 * nb, scr, lane); }
    }
}

__global__ void __launch_bounds__(NWAVES * 64, 2) mk_fwd(Args args) {
    extern __shared__ __attribute__((aligned(16))) unsigned char lds[];
    cg::grid_group grid = cg::this_grid();
    LAS unsigned char* ldsp = (LAS unsigned char*)lds;
    for (int u = threadIdx.x; u < (LDS_BYTES - RING_BYTES) / 4; u += NWAVES * 64) ((LAS unsigned*)(ldsp + RING_BYTES))[u] = 0u;
    __syncthreads();
    const XcdBarrier bar = xcd_barrier_post((unsigned*)(args.ws + WS_CTL) + CW_BAR, (volatile LAS unsigned*)(ldsp + MISC_OFF) + 8);
    grid.sync();
    const int G = gridDim.x; const int bx = blockIdx.x; const int vcu = (G % 8 == 0) ? (bx % 8) * (G / 8) + bx / 8 : bx;
    const int NGW = G * NWAVES;
#define LANE_WAVE() int tid_ = threadIdx.x; asm volatile("" : "+v"(tid_)); const int lane = tid_ & 63, wave = __builtin_amdgcn_readfirstlane(tid_ >> 6), gw = vcu * NWAVES + wave;
#define KARGS() ({ kargs_t p_ = (kargs_t)__builtin_amdgcn_kernarg_segment_ptr(); asm volatile("" : "+s"(p_)); p_; })
#define WSP(T, off) ((T*)(ap->ws + (off)))
#define GRID_SYNC() xcd_barrier(bar)
#pragma clang loop unroll(disable)
    for (int l = 0; l < DEPTH; ++l) {
        if (l == 0) {
            LANE_WAVE();
            kargs_t ap = KARGS();
            convert_weights(ap, 0, (LAS float*)(ldsp + wave * 16384), lane, gw, NGW);
            {   bf16* XB = WSP(bf16, WS_XB); float* PSS = WSP(float, WS_PSS);
                for (int m0 = gw; m0 < M; m0 += 4 * NGW) {
                    f32x4 v[4][4];
#pragma unroll
                    for (int q = 0; q < 4; ++q) { const int m = m0 + q * NGW; const GAS f32x4* xr = (const GAS f32x4*)(ap->in[0] + (size_t)(m < M ? m : 0) * DM) + lane;
#pragma unroll
                        for (int j = 0; j < 4; ++j) v[q][j] = xr[64 * j]; }
#pragma unroll
                    for (int q = 0; q < 4; ++q) { const int m = m0 + q * NGW; float s = 0.f;
#pragma unroll
                        for (int j = 0; j < 4; ++j) s += (v[q][j].x * v[q][j].x + v[q][j].y * v[q][j].y) + (v[q][j].z * v[q][j].z + v[q][j].w * v[q][j].w);
                        s = wave_sum(s);
                        if (m < M) { GAS unsigned long long* o8 = (GAS unsigned long long*)(XB + (size_t)m * DM) + lane;
#pragma unroll
                            for (int j = 0; j < 4; ++j) o8[64 * j] = (unsigned long long)pk2(v[q][j].x, v[q][j].y) | ((unsigned long long)pk2(v[q][j].z, v[q][j].w) << 32);
                            if (lane < 4) PSS[(size_t)lane * M + m] = (lane == 0) ? s : 0.f; } }
                }
            }
            GRID_SYNC();
        }
        {
            kargs_t ap = KARGS();
            pg8::Gemm g{WSP(bf16, WS_XB), WB(l, WS_WIN), M, INC, DM, 0, 0}; pg8::StaticOrder S; S.init(M, INC, G, bx);
            pg8::EpiInProj E{WSP(bf16, WS_QKV), WSP(bf16, WS_GATE), WSP(float, WS_PSS), ap->in[7] + l * 128, ap->in[8] + l * 128, ap->in[2] + l * 2048};
            pg8::gemm_phase<pg8::EpiInProj, pg8::StaticOrder, true, true>(ldsp, g, S, E);
            if (l + 1 < DEPTH) {
                const int nun = (M / 256) * (INC / 256), first_idle = nun - (nun / G) * G; int ncv = G, icv = bx;
                if (first_idle > 0 && first_idle < G) { ncv = G - first_idle; icv = bx - first_idle; }
                if (icv >= 0) { LANE_WAVE(); (void)gw; convert_weights(KARGS(), l + 1, (LAS float*)(ldsp + wave * 16384), lane, icv * NWAVES + wave, ncv * NWAVES); }
            }
        }
        GRID_SYNC();
        {
            kargs_t ap = KARGS(); bf16* QKV = WSP(bf16, WS_QKV); bf16* OA = WSP(bf16, WS_OA); bf16* OD0 = WSP(bf16, WS_OD0); bf16* OD1 = WSP(bf16, WS_OD1);
            const float LOG2E = 1.4426950408889634f;
            bool nomax_swa, nomax_diff;
            { LANE_WAVE(); (void)gw; (void)wave;
              float a0 = fabsf(ap->in[7][l * 128 + lane]), a1 = fabsf(ap->in[7][l * 128 + 64 + lane]), d0 = fabsf(ap->in[8][l * 128 + lane]), d1 = fabsf(ap->in[8][l * 128 + 64 + lane]);
#pragma unroll
              for (int o = 1; o < 64; o <<= 1) { a0 = fmaxf(a0, __shfl_xor(a0, o)); a1 = fmaxf(a1, __shfl_xor(a1, o)); d0 = fmaxf(d0, __shfl_xor(d0, o)); d1 = fmaxf(d1, __shfl_xor(d1, o)); }
              nomax_swa = (8.0f * LOG2E * 1.02f * a0 * a1) <= 40.0f; nomax_diff = (8.0f * LOG2E * 1.02f * d0 * d1) <= 40.0f; }
            attn_body::bf16x8 qfr[4]; bool pref = false;
            for (int v = vcu; v < 256; v += G) {
                for (int i = 0; i < 12; ++i) {
                    long rowbase; int qb, t0, qc, kc, vc, oc; bool win; float s2, sink2; bf16* Ob;
                    if (i < 8) {
                        const int s = v & 7, bhv = (v >> 3) + 32 * (i >> 2), ii = i & 3, b = bhv >> 4, h = (bhv >> 2) & 3, c = (bhv >> 1) & 1, vh = bhv & 1;
                        qb = (ii == 0) ? s : (ii == 1) ? 15 - s : (ii == 2) ? 16 + s : 31 - s; t0 = 0; win = false; rowbase = (long)b * SEQ;
                        qc = 768 + h * 128 + c * 64; kc = 1280 + h * 128 + c * 64; vc = 1792 + h * 128 + vh * 64; oc = h * 128 + vh * 64; Ob = c ? OD1 : OD0;
                        s2 = exp2f(-8.0f * (float)(9 + h) / 12.0f) * LOG2E; sink2 = -INFINITY;
                    } else {
                        const int ui = v * 4 + (i - 8), hq = (ui >> 5) & 7, b = ui >> 8; qb = ui & 31; t0 = qb > 0 ? 4 * qb - 2 : 0; win = true; rowbase = (long)b * SEQ;
                        qc = hq * 64; kc = 512 + (hq >> 2) * 64; vc = 640 + (hq >> 2) * 64; oc = hq * 64; Ob = OA;
                        s2 = exp2f(-8.0f * (float)(1 + hq) / 12.0f) * LOG2E; sink2 = ap->in[9][l * 8 + hq] * LOG2E;
                    }
                    int vn = v, in = i + 1; if (in == 12) { in = 0; vn = v + G; }
                    if (vn >= 256) in = -1;
                    attn_body::attn_unit<60>(rowbase, qb, t0, win, win ? nomax_swa : nomax_diff, (const attn_body::bf16*)QKV + qc, (const attn_body::bf16*)QKV + kc, (const attn_body::bf16*)QKV + vc, (attn_body::bf16*)Ob + oc, s2, sink2, (char*)lds,
                        qfr, pref, (const attn_body::bf16*)QKV, vn, in);
                    pref = in >= 0;
                }
            }
        }
        GRID_SYNC();
        {
            LANE_WAVE();
            kargs_t ap = KARGS(); bf16* OD0 = WSP(bf16, WS_OD0); bf16* OD1 = WSP(bf16, WS_OD1); bf16* OB = WSP(bf16, WS_OB);
            const float lam_init = 0.8f - 0.6f * expf(-0.3f * (float)l);
            const float* lp = ap->in[10] + l * 256;
            const float lam = expf(wave_sum(lp[lane] * lp[64 + lane])) - expf(wave_sum(lp[128 + lane] * lp[192 + lane])) + lam_init;
            const float* sl = ap->in[11] + l * 128 + (8 * lane & 127);
            float gsc[8];
#pragma unroll
            for (int i = 0; i < 8; ++i) gsc[i] = sl[i] * (1.0f - lam_init);
            for (int m0 = gw; m0 < M; m0 += 4 * NGW) {
                v4u a[4], b[4];
#pragma unroll
                for (int j = 0; j < 4; ++j) { const int m = m0 + j * NGW; if (m < M) { a[j] = *(const GAS v4u*)(OD0 + (size_t)m * 512 + 8 * lane); b[j] = *(const GAS v4u*)(OD1 + (size_t)m * 512 + 8 * lane); } else { a[j] = (v4u){0u, 0u, 0u, 0u}; b[j] = a[j]; } }
#pragma unroll
                for (int j = 0; j < 4; ++j) { const int m = m0 + j * NGW;
                    float o[8];
#pragma unroll
                    for (int i = 0; i < 4; ++i) { o[2 * i] = __uint_as_float(a[j][i] << 16) - lam * __uint_as_float(b[j][i] << 16); o[2 * i + 1] = __uint_as_float(a[j][i] & 0xffff0000u) - lam * __uint_as_float(b[j][i] & 0xffff0000u); }
                    float ss = 0.f;
#pragma unroll
                    for (int i = 0; i < 8; ++i) ss += o[i] * o[i];
                    ss += __shfl_xor(ss, 1); ss += __shfl_xor(ss, 2); ss += __shfl_xor(ss, 4); ss += __shfl_xor(ss, 8);
                    const float rn = __builtin_amdgcn_rsqf(ss * (1.0f / 128.0f) + 1e-6f);
                    v4u w;
#pragma unroll
                    for (int i = 0; i < 4; ++i) w[i] = pk2(o[2 * i] * rn * gsc[2 * i], o[2 * i + 1] * rn * gsc[2 * i + 1]);
                    if (m < M) *(GAS v4u*)(OB + (size_t)m * 512 + 8 * lane) = w; }
            }
        }
        GRID_SYNC();
        {
            kargs_t ap = KARGS();
            pg8::Gemm g{WSP(bf16, WS_OA), WB(l, WS_WB), M, DM, 512, (size_t)(WS_OB - WS_OA), (size_t)DM * 512 * 2}; pg8::ZOrder S; S.S.init(M, DM, G, bx);
            pg8::EpiGateMerge E{WSP(bf16, WS_GATE), WSP(bf16, WS_MRG)};
            pg8::gemm_phase<pg8::EpiGateMerge, pg8::ZOrder, true, true>(ldsp, g, S, E);
        }
        GRID_SYNC();
        {
            kargs_t ap = KARGS(); float* out = ap->out;
            pg8::Gemm g{WSP(bf16, WS_MRG), WB(l, WS_WO), M, DM, DM, 0, 0}; pg8::StaticOrder S; S.init(M, DM, G, bx);
            pg8::EpiResid E{nullptr, WSP(bf16, WS_XB), WSP(float, WS_PSS), (LAS float*)(ldsp + RING_BYTES + 1024)}; (void)out;
            pg8::gemm_phase<pg8::EpiResid, pg8::StaticOrder, true, true>(ldsp, g, S, E);
        }
        GRID_SYNC();
        {
            kargs_t ap = KARGS();
            pg8::Gemm g{WSP(bf16, WS_XB), WB(l, WS_W1), M, 2 * FFH, DM, 0, 0}; pg8::StaticOrder S; S.init(M, 2 * FFH, G, bx);
            pg8::EpiSwiGLU E{WSP(bf16, WS_ACT), WSP(float, WS_PSS)};
            pg8::gemm_phase<pg8::EpiSwiGLU, pg8::StaticOrder, true, true>(ldsp, g, S, E);
        }
        GRID_SYNC();
        {
            kargs_t ap = KARGS(); float* out = ap->out;
            pg8::Gemm g{WSP(bf16, WS_ACT), WB(l, WS_W2), M, DM, FFH, 0, 0}; pg8::StaticOrder S; S.init(M, DM, G, bx);
            pg8::EpiResid E{l == DEPTH - 1 ? out : nullptr, WSP(bf16, WS_XB), WSP(float, WS_PSS), (LAS float*)(ldsp + RING_BYTES + 1024)};
            pg8::gemm_phase<pg8::EpiResid, pg8::StaticOrder, true, true>(ldsp, g, S, E);
        }
        GRID_SYNC();
    }
}

extern "C" void kernel_launch(void* const* d_in, const int* in_sizes, int n_in, void* d_out, int out_size, void* d_ws, size_t ws_size, hipStream_t stream) {
    static int grid = 0;
    if (grid == 0) {
        if (n_in != 14 || in_sizes[0] != M * DM || out_size != M * DM || ws_size < WS_XB + 64 * MiB) { fprintf(stderr, "kernel_launch: unexpected shapes (n_in %d, in0 %d, out %d, ws %zu); nothing launched\n", n_in, n_in > 0 ? in_sizes[0] : -1, out_size, ws_size); grid = -1; return; }
        int dev = 0, cus = 0, per_cu = 0;
        if (hipGetDevice(&dev) != hipSuccess || hipDeviceGetAttribute(&cus, hipDeviceAttributeMultiprocessorCount, dev) != hipSuccess) { grid = -1; return; }
        if (hipFuncSetAttribute((const void*)mk_fwd, hipFuncAttributeMaxDynamicSharedMemorySize, LDS_BYTES) != hipSuccess) { fprintf(stderr, "kernel_launch: hipFuncSetAttribute failed\n"); grid = -1; return; }
        if (hipOccupancyMaxActiveBlocksPerMultiprocessor(&per_cu, (const void*)mk_fwd, NWAVES * 64, LDS_BYTES) != hipSuccess || per_cu < 1) { fprintf(stderr, "kernel_launch: occupancy query says %d\n", per_cu); per_cu = 1; }
        (void)hipGetLastError();
        grid = cus * per_cu;
    }
    if (grid < 0) return;
    if (hipMemsetAsync((char*)d_ws + WS_CTL, 0, CTL_ZERO_BYTES, stream) != hipSuccess) { fprintf(stderr, "kernel_launch: hipMemsetAsync failed\n"); return; }
    Args a{};
    for (int i = 0; i < 14; ++i) a.in[i] = (const float*)d_in[i];
    a.out = (float*)d_out; a.ws = (unsigned char*)d_ws;
    void* kargs[] = {&a};
    hipError_t e = hipLaunchCooperativeKernel((const void*)mk_fwd, dim3(grid), dim3(NWAVES * 64), kargs, LDS_BYTES, stream);
    if (e != hipSuccess) fprintf(stderr, "cooperative launch failed: %s (grid %d)\n", hipGetErrorString(e), grid);
}
```

```cpp
#include <hip/hip_runtime.h>
#include <hip/hip_cooperative_groups.h>
#include <cstdio>
#include <cstdint>
namespace cg = cooperative_groups;
namespace pg8 {
#define PG8_LAS __attribute__((address_space(3)))
typedef unsigned short bf16_t;
typedef short bf16x8 __attribute__((ext_vector_type(8)));
typedef float f32x4 __attribute__((ext_vector_type(4)));
typedef unsigned u32x4 __attribute__((ext_vector_type(4)));
constexpr int BM = 256, BK = 64, HALF = 128, HTB = HALF * BK * 2  , STAGE_BYTES = 8 * HTB, NXCD = 8, WGM = 4;

__host__ __device__ __forceinline__ int lds_byte(int r, int c) { const int st = (r >> 4) * 2 + (c >> 5), rr = r & 15, cc = c & 31, ob = rr * 64 + cc * 2; return st * 1024 + (ob ^ (((ob >> 9) & 1) << 5)); }
__host__ __device__ __forceinline__ void stage_rc(int b, int& R, int& C) { const int st = b / 1024, sb = b % 1024, swz = sb ^ (((sb >> 9) & 1) << 5); R = (st >> 1) * 16 + swz / 64; C = (st & 1) * 32 + (swz % 64) / 2; }
__host__ __device__ __forceinline__ int perm32(int rho) { const int n = rho >> 4, i = rho & 15; return 8 * (i >> 2) + 4 * n + (i & 3); }

struct Unit { int pm, pn, z; };
struct Gemm { const bf16_t* A; const bf16_t* Bt; int M, N, K; size_t zA, zB; };

struct StaticOrder {
    int nM, nN, nwg, G, c;
    __host__ __device__ void init(int M, int N, int G_, int c_) { nM = M / BM; nN = N / BM; nwg = nM * nN; G = G_; c = c_; }
    __host__ __device__ bool next(int i, Unit& u) const {
        const long L = (long)i * G + c; if (L >= nwg) return false;
        int wgid = (int)L; { const int q = nwg / NXCD, r = nwg % NXCD, xcd = wgid % NXCD, off = wgid / NXCD; wgid = (xcd < r ? xcd * (q + 1) : r * (q + 1) + (xcd - r) * q) + off; }
        const int nig = WGM * nN, gid = wgid / nig, fm = gid * WGM, gsz = (nM - fm) < WGM ? (nM - fm) : WGM;
        u.pm = fm + ((wgid % nig) % gsz); u.pn = (wgid % nig) / gsz; u.z = 0; return true;
    }
    __device__ __forceinline__ void a_ready(const Unit&) const {}
    __device__ __forceinline__ void done(const Unit&) const {}
};

typedef float f32x2_t __attribute__((ext_vector_type(2))); typedef __bf16 bf16x2_t __attribute__((ext_vector_type(2)));
__device__ __forceinline__ unsigned cvt_pk_bf16(float lo, float hi) { f32x2_t v = {lo, hi}; bf16x2_t b = __builtin_convertvector(v, bf16x2_t); return __builtin_bit_cast(unsigned, b); }
__device__ __forceinline__ u32x4 pack8(const f32x4 a, const f32x4 b) { u32x4 w; w.x = cvt_pk_bf16(a[0], a[1]); w.y = cvt_pk_bf16(a[2], a[3]); w.z = cvt_pk_bf16(b[0], b[1]); w.w = cvt_pk_bf16(b[2], b[3]); return w; }
__device__ __forceinline__ float bflo(unsigned w) { return __uint_as_float(w << 16); }
__device__ __forceinline__ float bfhi(unsigned w) { return __uint_as_float(w & 0xffff0000u); }
constexpr float RMS_EPS = 1e-6f;
constexpr float QC2 = 0.125f * 1.4426950408889634f;
constexpr int PSS_M = 32768;
__device__ __forceinline__ float row_rstd(const float* pss, int r, int fq) {
    float s = pss[(size_t)fq * PSS_M + r];
    s += __shfl_xor(s, 16); s += __shfl_xor(s, 32);
    return __builtin_amdgcn_rsqf(s * (1.0f / 1024.0f) + RMS_EPS);
}
__device__ __forceinline__ void rows_rstd8(const float* pss, int row0, int fq, float (&rs)[2][4]) {
    float p[8], q[8];
#pragma unroll
    for (int k = 0; k < 8; ++k) p[k] = pss[(size_t)fq * PSS_M + row0 + (k >> 2) * HALF + (k & 3) * 16];
    asm volatile("" : "+v"(p[0]), "+v"(p[1]), "+v"(p[2]), "+v"(p[3]), "+v"(p[4]), "+v"(p[5]), "+v"(p[6]), "+v"(p[7]));
#pragma unroll
    for (int k = 0; k < 8; ++k) q[k] = __shfl_xor(p[k], 16);
    asm volatile("" : "+v"(q[0]), "+v"(q[1]), "+v"(q[2]), "+v"(q[3]), "+v"(q[4]), "+v"(q[5]), "+v"(q[6]), "+v"(q[7]));
#pragma unroll
    for (int k = 0; k < 8; ++k) p[k] += q[k];
#pragma unroll
    for (int k = 0; k < 8; ++k) q[k] = __shfl_xor(p[k], 32);
    asm volatile("" : "+v"(q[0]), "+v"(q[1]), "+v"(q[2]), "+v"(q[3]), "+v"(q[4]), "+v"(q[5]), "+v"(q[6]), "+v"(q[7]));
#pragma unroll
    for (int k = 0; k < 8; ++k) rs[k >> 2][k & 3] = __builtin_amdgcn_rsqf((p[k] + q[k]) * (1.0f / 1024.0f) + RMS_EPS);
}
__device__ __forceinline__ void fq_sum8(float (&p)[8]) {
    float q[8];
#pragma unroll
    for (int k = 0; k < 8; ++k) q[k] = __shfl_xor(p[k], 16);
    asm volatile("" : "+v"(q[0]), "+v"(q[1]), "+v"(q[2]), "+v"(q[3]), "+v"(q[4]), "+v"(q[5]), "+v"(q[6]), "+v"(q[7]));
#pragma unroll
    for (int k = 0; k < 8; ++k) p[k] += q[k];
#pragma unroll
    for (int k = 0; k < 8; ++k) q[k] = __shfl_xor(p[k], 32);
    asm volatile("" : "+v"(q[0]), "+v"(q[1]), "+v"(q[2]), "+v"(q[3]), "+v"(q[4]), "+v"(q[5]), "+v"(q[6]), "+v"(q[7]));
#pragma unroll
    for (int k = 0; k < 8; ++k) p[k] += q[k];
}
struct EpiInProj {
    static constexpr bool PERM = true, AFTER_DRAIN = false;
    bf16_t* qkv; bf16_t* gate; const float* pss; const float* qkn_swa; const float* qkn_diff; const float* bgate;
    __device__ __forceinline__ bool keep(const Unit&) const { return false; }
    __device__ __forceinline__ void operator()(f32x4 (&acc)[2][2][4][2], const Unit& u, int wr, int wc, int fr, int fq) const {
        const int row0 = u.pm * BM + wr * 64 + fr;
        float rs[2][4];
        rows_rstd8(pss, row0, fq, rs);
        if (u.pn < 9) {
            const int lc0 = u.pn * 256 + wc * 64;
            const float* gp = nullptr; float sc = 1.f;
            if (lc0 < 512) { gp = qkn_swa; sc = QC2; } else if (lc0 < 640) { gp = qkn_swa + 64; } else if (lc0 < 768) { } else if (lc0 < 1280) { gp = qkn_diff; sc = QC2; } else if (lc0 < 1792) { gp = qkn_diff + 64; }
            f32x4 gv[2][2];
#pragma unroll
            for (int bj = 0; bj < 2; ++bj)
#pragma unroll
                for (int n = 0; n < 2; ++n) gv[bj][n] = gp ? *(const f32x4*)(gp + 32 * bj + 8 * fq + 4 * n) * sc : (f32x4){1.f, 1.f, 1.f, 1.f};
            float hs[8];
#pragma unroll
            for (int k = 0; k < 8; ++k) { float ss = 0.f;
#pragma unroll
                for (int bj = 0; bj < 2; ++bj)
#pragma unroll
                    for (int n = 0; n < 2; ++n) { const f32x4 q = acc[k >> 2][bj][k & 3][n] * acc[k >> 2][bj][k & 3][n]; ss += (q[0] + q[1]) + (q[2] + q[3]); }
                hs[k] = ss; }
            if (gp) fq_sum8(hs);
#pragma unroll
            for (int ai = 0; ai < 2; ++ai)
#pragma unroll
                for (int m = 0; m < 4; ++m) {
                    const int r = row0 + ai * HALF + m * 16; const float rstd = rs[ai][m];
                    float sc_row = rstd;
                    if (gp) sc_row = rstd * __builtin_amdgcn_rsqf(hs[ai * 4 + m] * (rstd * rstd) * (1.0f / 64.0f) + RMS_EPS);
                    bf16_t* rowp = qkv + (size_t)r * 2304 + lc0 + 8 * fq;
#pragma unroll
                    for (int bj = 0; bj < 2; ++bj) *(u32x4*)(rowp + 32 * bj) = pack8(acc[ai][bj][m][0] * sc_row * gv[bj][0], acc[ai][bj][m][1] * sc_row * gv[bj][1]);
                }
        } else {
            const int g0 = (u.pn - 9) * 256 + wc * 32 + 8 * fq;
            f32x4 bv[2][2];
#pragma unroll
            for (int bj = 0; bj < 2; ++bj)
#pragma unroll
                for (int n = 0; n < 2; ++n) bv[bj][n] = *(const f32x4*)(bgate + g0 + bj * HALF + 4 * n);
#pragma unroll
            for (int ai = 0; ai < 2; ++ai)
#pragma unroll
                for (int m = 0; m < 4; ++m) {
                    const int r = row0 + ai * HALF + m * 16; const float rstd = rs[ai][m];
                    bf16_t* rowp = gate + (size_t)r * 2048 + g0;
#pragma unroll
                    for (int bj = 0; bj < 2; ++bj) { f32x4 s[2];
#pragma unroll
                        for (int n = 0; n < 2; ++n) { const f32x4 v = acc[ai][bj][m][n] * rstd + bv[bj][n];
#pragma unroll
                            for (int i = 0; i < 4; ++i) s[n][i] = __builtin_amdgcn_rcpf(1.0f + __builtin_amdgcn_exp2f(v[i] * -1.4426950408889634f)); }
                        *(u32x4*)(rowp + bj * HALF) = pack8(s[0], s[1]); }
                }
        }
    }
};
struct EpiGateMerge {
    static constexpr bool PERM = true, AFTER_DRAIN = false;
    const bf16_t* gate; bf16_t* merged;
    __device__ __forceinline__ bool keep(const Unit& u) const { return u.z == 0; }
    __device__ __forceinline__ void operator()(f32x4 (&acc)[2][2][4][2], const Unit& u, int wr, int wc, int fr, int fq) const {
        const int row0 = u.pm * BM + wr * 64 + fr, col0 = u.pn * BM + wc * 32 + 8 * fq;
#pragma unroll
        for (int ai = 0; ai < 2; ++ai)
#pragma unroll
        for (int mh = 0; mh < 2; ++mh) {
            u32x4 g1v[2][2];
#pragma unroll
            for (int mm = 0; mm < 2; ++mm)
#pragma unroll
                for (int bj = 0; bj < 2; ++bj) g1v[mm][bj] = *(const u32x4*)(gate + (size_t)(row0 + ai * HALF + (2 * mh + mm) * 16) * 2048 + 1024 + col0 + bj * HALF);
#pragma unroll
            for (int mm = 0; mm < 2; ++mm)
#pragma unroll
                for (int bj = 0; bj < 2; ++bj) { const int m = 2 * mh + mm; const int r = row0 + ai * HALF + m * 16; const u32x4 g1 = g1v[mm][bj];
                    const f32x4 g1a = {bflo(g1.x), bfhi(g1.x), bflo(g1.y), bfhi(g1.y)}, g1b = {bflo(g1.z), bfhi(g1.z), bflo(g1.w), bfhi(g1.w)};
                    if (u.z == 0) {
                        const u32x4 g0 = *(const u32x4*)(gate + (size_t)r * 2048 + col0 + bj * HALF);
                        const f32x4 g0a = {bflo(g0.x), bfhi(g0.x), bflo(g0.y), bfhi(g0.y)}, g0b = {bflo(g0.z), bfhi(g0.z), bflo(g0.w), bfhi(g0.w)};
#pragma unroll
                        for (int i = 0; i < 4; ++i) { acc[ai][bj][m][0][i] *= g0a[i] * __builtin_amdgcn_rcpf(__builtin_fmaxf(g1a[i], 1e-30f)); acc[ai][bj][m][1][i] *= g0b[i] * __builtin_amdgcn_rcpf(__builtin_fmaxf(g1b[i], 1e-30f)); }
                    } else {
                        *(u32x4*)(merged + (size_t)r * 1024 + col0 + bj * HALF) = pack8(acc[ai][bj][m][0] * g1a, acc[ai][bj][m][1] * g1b); }
                }
        }
    }
};
struct EpiResid {
    static constexpr bool PERM = true, AFTER_DRAIN = false;
    float* xout; bf16_t* xb; float* pss; PG8_LAS float* red;
    __device__ __forceinline__ bool keep(const Unit&) const { return false; }
    __device__ __forceinline__ void operator()(f32x4 (&acc)[2][2][4][2], const Unit& u, int wr, int wc, int fr, int fq) const {
        const int row0 = u.pm * BM + wr * 64 + fr, col0 = u.pn * BM + wc * 32 + 8 * fq;
#pragma unroll
        for (int ai = 0; ai < 2; ++ai) {
            u32x4 xov[4][2];
#pragma unroll
            for (int m = 0; m < 4; ++m)
#pragma unroll
                for (int bj = 0; bj < 2; ++bj) xov[m][bj] = *(const u32x4*)(xb + (size_t)(row0 + ai * HALF + m * 16) * 1024 + col0 + bj * HALF);
            float ssv[8] = {0.f, 0.f, 0.f, 0.f, 0.f, 0.f, 0.f, 0.f};
#pragma unroll
            for (int m = 0; m < 4; ++m) {
                const int r = row0 + ai * HALF + m * 16; const size_t off = (size_t)r * 1024 + col0; float ss = 0.f;
#pragma unroll
                for (int bj = 0; bj < 2; ++bj) {
                    const u32x4 xo = xov[m][bj];
                    f32x4 xn[2]; xn[0] = (f32x4){bflo(xo.x), bfhi(xo.x), bflo(xo.y), bfhi(xo.y)} + acc[ai][bj][m][0]; xn[1] = (f32x4){bflo(xo.z), bfhi(xo.z), bflo(xo.w), bfhi(xo.w)} + acc[ai][bj][m][1];
#pragma unroll
                    for (int n = 0; n < 2; ++n) { const f32x4 q = xn[n] * xn[n]; ss += (q[0] + q[1]) + (q[2] + q[3]); if (xout) *(f32x4*)(xout + off + bj * HALF + 4 * n) = xn[n]; }
                    *(u32x4*)(xb + off + bj * HALF) = pack8(xn[0], xn[1]); }
                ssv[m] = ss;
            }
            fq_sum8(ssv);
#pragma unroll
            for (int m = 0; m < 4; ++m) if (fq == 0) red[(ai * HALF + wr * 64 + m * 16 + fr) * 4 + wc] = ssv[m];
        }
        asm volatile("s_waitcnt lgkmcnt(0)" ::: "memory"); __builtin_amdgcn_s_barrier(); asm volatile("" ::: "memory");
        { const int t = (wr * 4 + wc) * 64 + fq * 16 + fr;
          if (t < BM) { const f32x4 p = *(const PG8_LAS f32x4*)(red + t * 4); pss[(size_t)u.pn * PSS_M + u.pm * BM + t] = (p[0] + p[1]) + (p[2] + p[3]); } }
    }
};
struct EpiSwiGLU {
    static constexpr bool PERM = true, AFTER_DRAIN = false;
    bf16_t* act; const float* pss;
    __device__ __forceinline__ bool keep(const Unit&) const { return false; }
    __device__ __forceinline__ void operator()(f32x4 (&acc)[2][2][4][2], const Unit& u, int wr, int wc, int fr, int fq) const {
        const int row0 = u.pm * BM + wr * 64 + fr, col0 = u.pn * 128 + wc * 32 + 8 * fq;
        float rs[2][4];
        rows_rstd8(pss, row0, fq, rs);
#pragma unroll
        for (int ai = 0; ai < 2; ++ai)
#pragma unroll
            for (int m = 0; m < 4; ++m) {
                const int r = row0 + ai * HALF + m * 16; const float rstd = rs[ai][m]; f32x4 a[2];
#pragma unroll
                for (int n = 0; n < 2; ++n) { const f32x4 g = acc[ai][0][m][n] * rstd, uu = acc[ai][1][m][n] * rstd;
#pragma unroll
                    for (int i = 0; i < 4; ++i) a[n][i] = g[i] * __builtin_amdgcn_rcpf(1.0f + __builtin_amdgcn_exp2f(g[i] * -1.4426950408889634f)) * uu[i]; }
                *(u32x4*)(act + (size_t)r * 2816 + col0) = pack8(a[0], a[1]);
            }
    }
};
struct ZOrder {
    StaticOrder S;
    __device__ __forceinline__ bool next(int i, Unit& u) const { if (!S.next(i >> 1, u)) return false; u.z = i & 1; return true; }
    __device__ __forceinline__ void a_ready(const Unit&) const {}
    __device__ __forceinline__ void done(const Unit&) const {}
};

template <class Epi, class Sched, bool ALIGN_EPI = false, bool SP2 = false>
__device__ __forceinline__ void gemm_phase(PG8_LAS unsigned char* lds, const Gemm g, const Sched& S, const Epi& E) {
    int tid = threadIdx.x; asm volatile("" : "+v"(tid));
    const int wid = __builtin_amdgcn_readfirstlane(tid >> 6), lane = tid & 63, wr = wid >> 2, wc = wid & 3, fr = lane & 15, fq = lane >> 4;
    const int K = g.K, nt = K / BK;
    unsigned voffA[2], voffB[2];
#pragma unroll
    for (int i = 0; i < 2; ++i) { int R, C; stage_rc(tid * 16 + i * 8192, R, C); const int Rb = Epi::PERM ? ((R & ~31) + perm32(R & 31)) : R;
        voffA[i] = (unsigned)(R * K + C) * 2u; voffB[i] = (unsigned)(Rb * K + C) * 2u; }
    const size_t kstep = (size_t)(BK * 2);
    const size_t hstep = (size_t)HALF * K * 2;
    const size_t tstep = 2 * hstep;
    const unsigned ldsw = (unsigned)wid * 1024u;
    const int aoff = lds_byte(wr * 64 + fr, fq * 8), boff = lds_byte(wc * 32 + fr, fq * 8);
#define PG8_SA(b, h) (((b) * 2 + (h)) * HTB)
#define PG8_SB(b, h) ((4 + (b) * 2 + (h)) * HTB)
#define PG8_STAGE(bufoff, gbase, voff) do { _Pragma("unroll") for (int _i = 0; _i < 2; ++_i) \
        __builtin_amdgcn_global_load_lds((const unsigned*)((const char*)(gbase) + (voff)[_i]), (PG8_LAS unsigned*)(lds + (bufoff) + ldsw + _i * 8192), 16, 0, 0); } while (0)
#define PG8_LDA(dst, b, h) do { _Pragma("unroll") for (int m = 0; m < 4; ++m) _Pragma("unroll") for (int k = 0; k < 2; ++k) dst[m][k] = *(const PG8_LAS bf16x8*)(lds + PG8_SA(b, h) + aoff + m * 2048 + k * 1024); } while (0)
#define PG8_LDB(dst, b, h) do { _Pragma("unroll") for (int n = 0; n < 2; ++n) _Pragma("unroll") for (int k = 0; k < 2; ++k) dst[n][k] = *(const PG8_LAS bf16x8*)(lds + PG8_SB(b, h) + boff + n * 2048 + k * 1024); } while (0)
#define PG8_MMA(ai, bj, At, Bt) do { __builtin_amdgcn_s_setprio(1); _Pragma("unroll") for (int m = 0; m < 4; ++m) _Pragma("unroll") for (int n = 0; n < 2; ++n) _Pragma("unroll") for (int k = 0; k < 2; ++k) \
        acc[ai][bj][m][n] = __builtin_amdgcn_mfma_f32_16x16x32_bf16(Bt[n][k], At[m][k], acc[ai][bj][m][n], 0, 0, 0); __builtin_amdgcn_s_setprio(0); } while (0)
#define PG8_WAIT_V(n) asm volatile("s_waitcnt vmcnt(" #n ")" ::: "memory")
#define PG8_WAIT_L(n) asm volatile("s_waitcnt lgkmcnt(" #n ")" ::: "memory")
#define PG8_BAR __builtin_amdgcn_s_barrier()
#define PG8_SCHED __builtin_amdgcn_sched_barrier(0)
    Unit cur, nxt; int ui = 0;
    if (!S.next(0, cur)) return;
    f32x4 acc[2][2][4][2];
#pragma unroll
    for (int a = 0; a < 2; ++a)
#pragma unroll
        for (int b = 0; b < 2; ++b)
#pragma unroll
            for (int m = 0; m < 4; ++m)
#pragma unroll
                for (int n = 0; n < 2; ++n) acc[a][b][m][n] = (f32x4){0.f, 0.f, 0.f, 0.f};
    bf16x8 At[4][2], B0[2][2], B1[2][2];
    const char* cA = (const char*)g.A + (size_t)cur.pm * tstep + (size_t)cur.z * g.zA; const char* cB = (const char*)g.Bt + (size_t)cur.pn * tstep + (size_t)cur.z * g.zB;
    S.a_ready(cur);
    if constexpr (SP2) {
        PG8_STAGE(PG8_SB(0, 0), cB, voffB); PG8_STAGE(PG8_SB(0, 1), cB + hstep, voffB); PG8_STAGE(PG8_SA(0, 0), cA, voffA); PG8_STAGE(PG8_SA(0, 1), cA + hstep, voffA);
        if (wr == 1) PG8_BAR;
        PG8_WAIT_V(2); PG8_BAR;
        PG8_STAGE(PG8_SB(1, 0), cB + kstep, voffB); PG8_STAGE(PG8_SA(1, 0), cA + kstep, voffA); PG8_STAGE(PG8_SB(1, 1), cB + hstep + kstep, voffB);
        PG8_WAIT_V(6); PG8_BAR;
    } else {
        PG8_STAGE(PG8_SB(0, 0), cB, voffB); PG8_STAGE(PG8_SA(0, 0), cA, voffA); PG8_STAGE(PG8_SB(0, 1), cB + hstep, voffB); PG8_STAGE(PG8_SA(0, 1), cA + hstep, voffA);
        if (wr == 1) PG8_BAR;
        PG8_WAIT_V(4); PG8_BAR;
        PG8_STAGE(PG8_SB(1, 0), cB + kstep, voffB); PG8_STAGE(PG8_SA(1, 0), cA + kstep, voffA); PG8_STAGE(PG8_SB(1, 1), cB + hstep + kstep, voffB);
        PG8_WAIT_V(6); PG8_BAR;
    }
    for (;;) {
        const bool has_next = S.next(ui + 1, nxt);
        const char* nA = has_next ? (const char*)g.A + (size_t)nxt.pm * tstep + (size_t)nxt.z * g.zA : cA; const char* nB = has_next ? (const char*)g.Bt + (size_t)nxt.pn * tstep + (size_t)nxt.z * g.zB : cB;
        for (int t = 0; t < nt; t += 2) {
            const bool last = (t == nt - 2);
            const char* a1 = cA + (size_t)(t + 1) * kstep;
            const char* a2 = last ? nA : cA + (size_t)(t + 2) * kstep; const char* b2 = last ? nB : cB + (size_t)(t + 2) * kstep;
            const char* a3 = a2 + kstep; const char* b3 = b2 + kstep;
            if (last && has_next) S.a_ready(nxt);
            if constexpr (SP2) {
            PG8_LDB(B0, 0, 0); PG8_LDB(B1, 0, 1); PG8_SCHED; PG8_LDA(At, 0, 0); PG8_STAGE(PG8_SA(1, 1), a1 + hstep, voffA);
            PG8_WAIT_V(8); PG8_WAIT_L(0); PG8_BAR; PG8_MMA(0, 0, At, B0); PG8_MMA(0, 1, At, B1); PG8_BAR; PG8_SCHED;
            PG8_LDA(At, 0, 1); PG8_STAGE(PG8_SB(0, 0), b2, voffB); PG8_STAGE(PG8_SB(0, 1), b2 + hstep, voffB); PG8_STAGE(PG8_SA(0, 0), a2, voffA);
            PG8_WAIT_V(8); PG8_WAIT_L(0); PG8_BAR; PG8_MMA(1, 0, At, B0); PG8_MMA(1, 1, At, B1); PG8_BAR; PG8_SCHED;
            PG8_LDB(B0, 1, 0); PG8_LDB(B1, 1, 1); PG8_SCHED; PG8_LDA(At, 1, 0); PG8_STAGE(PG8_SA(0, 1), a2 + hstep, voffA);
            PG8_WAIT_V(8); PG8_WAIT_L(0); PG8_BAR; PG8_MMA(0, 0, At, B0); PG8_MMA(0, 1, At, B1); PG8_BAR; PG8_SCHED;
            PG8_LDA(At, 1, 1); PG8_STAGE(PG8_SB(1, 0), b3, voffB); PG8_STAGE(PG8_SB(1, 1), b3 + hstep, voffB); PG8_STAGE(PG8_SA(1, 0), a3, voffA);
            PG8_WAIT_V(8); PG8_WAIT_L(0); PG8_BAR; PG8_MMA(1, 0, At, B0); PG8_MMA(1, 1, At, B1); PG8_BAR; PG8_SCHED;
            } else {
            PG8_LDB(B0, 0, 0); PG8_SCHED; PG8_LDA(At, 0, 0); PG8_STAGE(PG8_SA(1, 1), a1 + hstep, voffA);
            PG8_WAIT_L(8); PG8_BAR; PG8_WAIT_L(0); PG8_MMA(0, 0, At, B0); PG8_BAR; PG8_SCHED;
            PG8_LDB(B1, 0, 1); PG8_STAGE(PG8_SB(0, 0), b2, voffB);
            PG8_BAR; PG8_WAIT_L(0); PG8_MMA(0, 1, At, B1); PG8_BAR;
            PG8_LDA(At, 0, 1); PG8_STAGE(PG8_SA(0, 0), a2, voffA);
            PG8_BAR; PG8_WAIT_L(0); PG8_MMA(1, 0, At, B0); PG8_BAR; PG8_SCHED;
            PG8_STAGE(PG8_SB(0, 1), b2 + hstep, voffB);
            PG8_WAIT_V(6); PG8_BAR; PG8_MMA(1, 1, At, B1); PG8_BAR;
            PG8_LDB(B0, 1, 0); PG8_SCHED; PG8_LDA(At, 1, 0); PG8_STAGE(PG8_SA(0, 1), a2 + hstep, voffA);
            PG8_WAIT_L(8); PG8_BAR; PG8_WAIT_L(0); PG8_MMA(0, 0, At, B0); PG8_BAR; PG8_SCHED;
            PG8_LDB(B1, 1, 1); PG8_STAGE(PG8_SB(1, 0), b3, voffB);
            PG8_BAR; PG8_WAIT_L(0); PG8_MMA(0, 1, At, B1); PG8_BAR;
            PG8_LDA(At, 1, 1); PG8_STAGE(PG8_SA(1, 0), a3, voffA);
            PG8_BAR; PG8_WAIT_L(0); PG8_MMA(1, 0, At, B0); PG8_BAR; PG8_SCHED;
            PG8_STAGE(PG8_SB(1, 1), b3 + hstep, voffB);
            PG8_WAIT_V(6); PG8_BAR; PG8_MMA(1, 1, At, B1); PG8_BAR;
            }
        }
        if constexpr (ALIGN_EPI) { if (wr == 0) PG8_BAR; }
        if constexpr (!Epi::AFTER_DRAIN) { E(acc, cur, wr, wc, fr, fq); S.done(cur); }
        if (!has_next) break;
        if (!E.keep(cur)) {
#pragma unroll
        for (int a = 0; a < 2; ++a)
#pragma unroll
            for (int b = 0; b < 2; ++b)
#pragma unroll
                for (int m = 0; m < 4; ++m)
#pragma unroll
                    for (int n = 0; n < 2; ++n) acc[a][b][m][n] = (f32x4){0.f, 0.f, 0.f, 0.f};
        }
        cur = nxt; cA = nA; cB = nB; ++ui;
        if constexpr (ALIGN_EPI) { if (wr == 1) PG8_BAR; }
    }
    PG8_WAIT_V(0);
    if constexpr (!ALIGN_EPI) { if (wr == 0) PG8_BAR; }
    PG8_BAR;
    if constexpr (Epi::AFTER_DRAIN) { E.fused(acc, cur, wr, wc, fr, fq, lds, wid, lane); S.done(cur); }
#undef PG8_SA
#undef PG8_SB
#undef PG8_STAGE
#undef PG8_LDA
#undef PG8_LDB
#undef PG8_MMA
#undef PG8_WAIT_V
#undef PG8_WAIT_L
#undef PG8_BAR
#undef PG8_SCHED
}
}
#include <hip/hip_bf16.h>
#include <cmath>
namespace attn_body {
using bf16=__hip_bfloat16;
using bf16x8=__attribute__((ext_vector_type(8)))short;
using s16x4=__attribute__((ext_vector_type(4)))short;
using f32x16=__attribute__((ext_vector_type(16)))float;
using u32x4=__attribute__((ext_vector_type(4)))unsigned;
constexpr int SEQ=8192,D=64,PIN=2304,POUT=512;
constexpr int NW=8,QBLK=32,QB=QBLK*NW,KVBLK=64,NQB=SEQ/QB;
constexpr int ATTN_UNIT_ROWS=QB;
__device__ __forceinline__ int crow(int r,int hi){return (r&3)+8*(r>>2)+4*hi;}
#define SBAR() __builtin_amdgcn_sched_barrier(0)
__device__ __forceinline__ void gmask(f32x16&p0,f32x16&p1,int kvb,int qrel,int hi,bool WIN){
  const float NEG=-INFINITY; int kb=kvb+4*hi;
  #pragma unroll
  for(int r=0;r<16;++r){int kv=kb+(r&3)+8*(r>>2); if(kv>qrel)p0[r]=NEG; if(kv+32>qrel)p1[r]=NEG;
    if(WIN){ if(kv<=qrel-128)p0[r]=NEG; if(kv+32<=qrel-128)p1[r]=NEG; } }
}

constexpr int NSLOT=3, SLOTB=8192;
constexpr int LDS_K=0, LDS_V=NSLOT*SLOTB, LDS_WS=2*NSLOT*SLOTB, LDS_OST=LDS_WS+NW*64*4, LDS_BYTES=LDS_OST+NW*4096;
constexpr float C2=0.125f*1.4426950408889634f;
__device__ __forceinline__ void glds16(const void*gsrc,unsigned lds_dst){unsigned keep;
  asm volatile("s_mov_b32 %0, m0\n\ts_mov_b32 m0, %2\n\ts_nop 0\n\tglobal_load_lds_dwordx4 %1, off\n\ts_mov_b32 m0, %0":"=&s"(keep):"v"(gsrc),"s"(lds_dst):"memory");}
__device__ __forceinline__ float max3f(float a,float b,float c){float r;asm("v_max3_f32 %0, %1, %2, %3":"=v"(r):"v"(a),"v"(b),"v"(c));return r;}
__device__ __forceinline__ float max2f(float a,float b){float r;asm("v_max_f32_e32 %0, %1, %2":"=v"(r):"v"(a),"v"(b));return r;}
__device__ __forceinline__ float fadd_s(float a,float b){float r;asm("v_add_f32_e32 %0, %1, %2":"=v"(r):"v"(a),"v"(b));return r;}
__device__ __forceinline__ float fsub_s(float a,float b){float r;asm("v_sub_f32_e32 %0, %1, %2":"=v"(r):"v"(a),"v"(b));return r;}
typedef float f32x2_t __attribute__((ext_vector_type(2))); typedef __bf16 bf16x2_t __attribute__((ext_vector_type(2)));
__device__ __forceinline__ unsigned cvtpk_s(float lo,float hi){f32x2_t v={lo,hi};bf16x2_t b=__builtin_convertvector(v,bf16x2_t);return __builtin_bit_cast(unsigned,b);}
#define WAIT_BAR(N) asm volatile("s_waitcnt vmcnt(" #N ") lgkmcnt(0)\n\ts_barrier":::"memory")

__device__ __forceinline__ void qkt(f32x16&p0,f32x16&p1,const char*Kslot,const bf16x8*qr,int r32,int hi){
  const char*kb=Kslot+hi*1024+r32*16;
  #pragma unroll
  for(int d0=0;d0<4;++d0){
    const bf16x8 b0=*reinterpret_cast<const bf16x8*>(kb+d0*2048);
    const bf16x8 b1=*reinterpret_cast<const bf16x8*>(kb+d0*2048+512);
    p0=__builtin_amdgcn_mfma_f32_32x32x16_bf16(b0,qr[d0],p0,0,0,0);p1=__builtin_amdgcn_mfma_f32_32x32x16_bf16(b1,qr[d0],p1,0,0,0);}
}
typedef __attribute__((address_space(3))) const char* lds_cptr;
typedef short v4i16_t __attribute__((ext_vector_type(4)));
__device__ __forceinline__ void kload8(bf16x8*kf,lds_cptr kp){
  kf[0]=*(const __attribute__((address_space(3))) bf16x8*)(kp);      kf[1]=*(const __attribute__((address_space(3))) bf16x8*)(kp+512);
  kf[2]=*(const __attribute__((address_space(3))) bf16x8*)(kp+2048); kf[3]=*(const __attribute__((address_space(3))) bf16x8*)(kp+2560);
  kf[4]=*(const __attribute__((address_space(3))) bf16x8*)(kp+4096); kf[5]=*(const __attribute__((address_space(3))) bf16x8*)(kp+4608);
  kf[6]=*(const __attribute__((address_space(3))) bf16x8*)(kp+6144); kf[7]=*(const __attribute__((address_space(3))) bf16x8*)(kp+6656);
}
__device__ __forceinline__ void kload2(bf16x8*kf,lds_cptr kp,int j){ kf[2*j]=*(const __attribute__((address_space(3))) bf16x8*)(kp+j*2048); kf[2*j+1]=*(const __attribute__((address_space(3))) bf16x8*)(kp+j*2048+512); }
__device__ __forceinline__ s16x4 vtr(lds_cptr p){ return __builtin_bit_cast(s16x4,__builtin_amdgcn_ds_read_tr16_b64_v4i16((__attribute__((address_space(3))) v4i16_t*)p)); }
__device__ __forceinline__ float rowmax(const f32x16&p0,const f32x16&p1){
  float a=max3f(p0[0],p0[1],p1[0]),b=max3f(p0[2],p0[3],p1[1]);a=max3f(a,p1[2],p1[3]);
  #pragma unroll
  for(int r=4;r<16;r+=4){a=max3f(a,p0[r],p0[r+1]);b=max3f(b,p0[r+2],p0[r+3]);a=max3f(a,p1[r],p1[r+1]);b=max3f(b,p1[r+2],p1[r+3]);}
  const float m=max2f(a,b);
  auto rr=__builtin_amdgcn_permlane32_swap(__float_as_uint(m),__float_as_uint(m),false,false);
  return max2f(__uint_as_float(rr[0]),__uint_as_float(rr[1]));
}
__device__ __forceinline__ void pv(f32x16*o,int vb,bf16x8 pa0,bf16x8 pa1,bf16x8 pa2,bf16x8 pa3){
  #pragma unroll
  for(int d0=0;d0<2;++d0){s16x4 lo[4],hi[4];
    #pragma unroll
    for(int ks=0;ks<4;++ks){
      asm volatile("ds_read_b64_tr_b16 %0,%1 offset:%c2":"=&v"(lo[ks]):"v"(vb),"i"(d0*4096+ks*1024):"memory");
      asm volatile("ds_read_b64_tr_b16 %0,%1 offset:%c2":"=&v"(hi[ks]):"v"(vb),"i"(d0*4096+ks*1024+512):"memory");}
    asm volatile("s_waitcnt lgkmcnt(0)":::"memory");SBAR();
    #define PK(k) (bf16x8){lo[k][0],lo[k][1],lo[k][2],lo[k][3],hi[k][0],hi[k][1],hi[k][2],hi[k][3]}
    o[d0]=__builtin_amdgcn_mfma_f32_32x32x16_bf16(pa0,PK(0),o[d0],0,0,0);
    o[d0]=__builtin_amdgcn_mfma_f32_32x32x16_bf16(pa1,PK(1),o[d0],0,0,0);
    o[d0]=__builtin_amdgcn_mfma_f32_32x32x16_bf16(pa2,PK(2),o[d0],0,0,0);
    o[d0]=__builtin_amdgcn_mfma_f32_32x32x16_bf16(pa3,PK(3),o[d0],0,0,0);
    #undef PK
  }
}

#ifndef ATTN_STORE16
#define ATTN_STORE16(p,v) (*(u32x4*)(p)=(v))
#endif
__device__ __forceinline__ void unit_qk_offsets(int vv,int ii,long&qo,long&ko){
  int q_,t_,qc_,kc_; long rb;
  if(ii<8){ const int s=vv&7,bhv=(vv>>3)+32*(ii>>2),i4=ii&3,b=bhv>>4,h=(bhv>>2)&3,c=(bhv>>1)&1;
    q_=(i4==0)?s:(i4==1)?15-s:(i4==2)?16+s:31-s; t_=0; rb=(long)b*SEQ; qc_=768+h*128+c*64; kc_=1280+h*128+c*64; }
  else{ const int ui=vv*4+(ii-8),hq=(ui>>5)&7,b=ui>>8; q_=ui&31; t_=q_>0?4*q_-2:0; rb=(long)b*SEQ; qc_=hq*64; kc_=512+(hq>>2)*64; }
  qo=qc_+(rb+(long)q_*QB)*PIN; ko=kc_+(rb+(long)t_*KVBLK)*PIN;
}
template<int THRL> __device__ __forceinline__ void attn_unit(long rowbase,int qb,int t0,bool WIN,bool NOMAX,const bf16*Qc,const bf16*__restrict__ Kc,const bf16*__restrict__ Vc,bf16*Oc,float s2,float sink2,char*shm,
    bf16x8 (&qr)[4],bool pref,const bf16*qkvb,int vn,int in_){
  int tid=threadIdx.x; asm volatile("":"+v"(tid)); const int lane=tid&63,r32=lane&31,hi=lane>>5; const int wid=__builtin_amdgcn_readfirstlane(tid>>6);
  const int q0=qb*QB;
  const bf16*Qw=Qc+(rowbase+q0+wid*QBLK)*PIN;
  const bf16*Kh=Kc+(rowbase+(long)t0*KVBLK)*PIN,*Vh=Vc+(rowbase+(long)t0*KVBLK)*PIN;
  const unsigned lds0=(unsigned)(uintptr_t)shm;
  float*wsf=(float*)(shm+LDS_WS)+wid*64;
  const bf16*ksrc=Kh+(long)lane*PIN+wid*8;
  const bf16*vsrc=Vh+(long)(16*(wid&3)+(lane>>2))*PIN+(wid>>2)*32+(lane&3)*8;
  const unsigned kdst=lds0+LDS_K+wid*1024, vdst=lds0+LDS_V+wid*1024;
  #define DMA_K(t,slot) glds16(ksrc+(long)(t)*KVBLK*PIN,(unsigned)__builtin_amdgcn_readfirstlane(kdst+(slot)))
  #define DMA_V(t,slot) glds16(vsrc+(long)(t)*KVBLK*PIN,(unsigned)__builtin_amdgcn_readfirstlane(vdst+(slot)))
  const int vb0=(int)(lds0+LDS_V)+((lane>>4)&1)*32+(lane&3)*8+(4*hi+((lane&15)>>2))*64;
  const char*Kbase=shm+LDS_K; bf16x8 kf[8];
  const lds_cptr shm3=(lds_cptr)shm; const lds_cptr kp0=shm3+LDS_K+hi*1024+r32*16; const lds_cptr vp0=shm3+LDS_V+((lane>>4)&1)*32+(lane&3)*8+(4*hi+((lane&15)>>2))*64;
  const int NT=(q0+QB)/KVBLK-t0;
  if(!pref){ DMA_K(0,0);DMA_V(0,0);DMA_K(1,SLOTB);
    _Pragma("unroll") for(int d0=0;d0<4;++d0)qr[d0]=*reinterpret_cast<const bf16x8*>(&Qw[(long)r32*PIN+d0*16+hi*8]);
  } else { DMA_V(0,0); }
  float mhat=0.f,l_reg=0.f;f32x16 o[2];o[0]=f32x16{};o[1]=f32x16{};
  const int qrel=q0-t0*KVBLK+wid*QBLK+r32;
  const float qb2=s2*(float)(qrel-4*hi);
  #define CINIT(C0,C1,btl) do{ const float b_=(btl); _Pragma("unroll") for(int r=0;r<16;++r){ C0[r]=__builtin_fmaf(s2,(float)((r&3)+8*(r>>2)),b_); C1[r]=__builtin_fmaf(s2,(float)((r&3)+8*(r>>2)+32),b_);} }while(0)
  #define CMASK(P0,P1,t) do{ if(WIN||(t)>=NT-4)gmask(P0,P1,64*(t),qrel,hi,WIN);}while(0)
  bool resc=false;
  #define START(P0,P1) do{ resc=false; \
    if(!NOMAX){ const float rm=rowmax(P0,P1); const float dl=__builtin_fmaxf(rm,0.f);     \
      mhat=fadd_s(mhat,dl); \
      _Pragma("unroll") for(int r=0;r<16;++r){P0[r]=fsub_s(P0[r],dl);P1[r]=fsub_s(P1[r],dl);} } \
    _Pragma("unroll") for(int r=0;r<16;++r)P0[r]=__builtin_amdgcn_exp2f(P0[r]); }while(0)
  #define RESC() do{ if(resc){ asm volatile("s_waitcnt lgkmcnt(0)":::"memory"); \
      _Pragma("unroll") for(int d_=0;d_<2;++d_) _Pragma("unroll") for(int r=0;r<16;++r)o[d_][r]*=wsf[crow(r,hi)]; } }while(0)
  f32x16 pA0,pA1,pB0,pB1;
  int sl_prev=0,sl_cur=0,sl_next=SLOTB;
  #define ROT() do{sl_prev=sl_cur;sl_cur=sl_next;sl_next=(sl_next==(NSLOT-1)*SLOTB)?0:sl_next+SLOTB;}while(0)
  if(!pref){ DMA_K(2,2*SLOTB);
    WAIT_BAR(3); }
  else { WAIT_BAR(5); }
  CINIT(pA0,pA1,-qb2); qkt(pA0,pA1,Kbase,qr,r32,hi);asm volatile("s_nop 15\n\ts_nop 7":"+v"(pA0),"+v"(pA1));CMASK(pA0,pA1,0);
  START(pA0,pA1);
  _Pragma("unroll") for(int r=0;r<16;++r)pA1[r]=__builtin_amdgcn_exp2f(pA1[r]);
  WAIT_BAR(0);
  DMA_K(3,0);DMA_V(1,SLOTB);
  ROT();
  kload8(kf,kp0+sl_cur);
  CINIT(pB0,pB1,__builtin_fmaf(s2,64.f,-qb2)-mhat); asm volatile("":"+v"(pB0)); asm volatile("":"+v"(pB1));
  WAIT_BAR(2);
  s16x4 vlo[8],vhi[8]; u32x4 pw0,pw1,pw2,pw3;
  #define PKW(P,B) cvtpk_s(P[B],P[B+1])
  #define PAF(k) __builtin_bit_cast(bf16x8,pw##k)
  #define VFR(i) (bf16x8){vlo[i][0],vlo[i][1],vlo[i][2],vlo[i][3],vhi[i][0],vhi[i][1],vhi[i][2],vhi[i][3]}
  #define PIN(x) asm volatile("":"+v"(x))
  #define MX3(a,b,c) __builtin_fmaxf(__builtin_fmaxf((a),(b)),(c))
  #define GAPA(MF,A0,A1,A2,A3,W0,W1,PW) do{ MF; sacc+=A0; sacc+=A1; sacc+=A2; sacc+=A3; PIN(sacc); W0; W1; PIN(PW); SBAR(); }while(0)
  #define EX(v) __builtin_amdgcn_exp2f(v)
  #define GAPB(MF,X,B) do{ MF; X[B]=EX(X[B]); X[B+1]=EX(X[B+1]); X[B+2]=EX(X[B+2]); X[B+3]=EX(X[B+3]); PIN(X); SBAR(); }while(0)
  #define VRD(i) do{ vlo[i]=vtr(vp_+(((i)>>2)*4096+((i)&3)*1024)); vhi[i]=vtr(vp_+(((i)>>2)*4096+((i)&3)*1024+512)); }while(0)
  #define KRD(G,j) do{ if(G){ kload2(kf,kp0+sl_next,j); SBAR(); } }while(0)
  #define STEP(C0,C1,P0,P1,t,GK,GV,GL) do{ SBAR();     \
    const lds_cptr vp_=vp0+sl_prev; \
    VRD(0); SBAR(); float sacc=(P0[0]+P0[1]); \
    GAPA(C0=__builtin_amdgcn_mfma_f32_32x32x16_bf16(kf[0],qr[0],C0,0,0,0), P0[2],P0[3],P0[4],P0[5],     pw0[0]=PKW(P0,0), pw0[1]=PKW(P0,2), pw0); \
    VRD(4); SBAR(); GAPA(C1=__builtin_amdgcn_mfma_f32_32x32x16_bf16(kf[1],qr[0],C1,0,0,0), P0[6],P0[7],P0[8],P0[9],     pw0[2]=PKW(P0,4), pw0[3]=PKW(P0,6), pw0); \
    VRD(1); SBAR(); GAPA(C0=__builtin_amdgcn_mfma_f32_32x32x16_bf16(kf[2],qr[1],C0,0,0,0),   P0[10],P0[11],P0[12],P0[13], pw1[0]=PKW(P0,8), pw1[1]=PKW(P0,10), pw1); \
    VRD(5); SBAR(); GAPA(C1=__builtin_amdgcn_mfma_f32_32x32x16_bf16(kf[3],qr[1],C1,0,0,0),   P0[14],P0[15],P1[0],P1[1],   pw1[2]=PKW(P0,12),pw1[3]=PKW(P0,14), pw1); \
    VRD(2); SBAR(); GAPA(C0=__builtin_amdgcn_mfma_f32_32x32x16_bf16(kf[4],qr[2],C0,0,0,0),   P1[2],P1[3],P1[4],P1[5],     pw2[0]=PKW(P1,0), pw2[1]=PKW(P1,2), pw2); \
    VRD(6); SBAR(); GAPA(C1=__builtin_amdgcn_mfma_f32_32x32x16_bf16(kf[5],qr[2],C1,0,0,0),   P1[6],P1[7],P1[8],P1[9],     pw2[2]=PKW(P1,4), pw2[3]=PKW(P1,6), pw2); \
    VRD(3); SBAR(); GAPA(C0=__builtin_amdgcn_mfma_f32_32x32x16_bf16(kf[6],qr[3],C0,0,0,0),   P1[10],P1[11],P1[12],P1[13], pw3[0]=PKW(P1,8), pw3[1]=PKW(P1,10), pw3); \
    VRD(7); SBAR(); GAPA(C1=__builtin_amdgcn_mfma_f32_32x32x16_bf16(kf[7],qr[3],C1,0,0,0),   P1[14],P1[15],0.f,0.f,       pw3[2]=PKW(P1,12),pw3[3]=PKW(P1,14), pw3); \
    l_reg+=sacc; \
    if(GK){DMA_K((t)+3,sl_cur);} if(GV){DMA_V((t)+1,sl_next);} \
    CMASK(C0,C1,t); \
    if(!NOMAX){ float a=MX3(C0[0],C0[1],C1[0]),b=MX3(C0[2],C0[3],C1[1]); a=MX3(a,C1[2],C1[3]); \
      _Pragma("unroll") for(int r=4;r<16;r+=4){a=MX3(a,C0[r],C0[r+1]);b=MX3(b,C0[r+2],C0[r+3]);a=MX3(a,C1[r],C1[r+1]);b=MX3(b,C1[r+2],C1[r+3]);} \
      float rm=__builtin_fmaxf(a,b); { auto rr=__builtin_amdgcn_permlane32_swap(__float_as_uint(rm),__float_as_uint(rm),false,false); rm=__builtin_fmaxf(__uint_as_float(rr[0]),__uint_as_float(rr[1])); } \
      resc=false; \
      if(__builtin_expect(__any(rm>(float)THRL),0)){ const float dl=__builtin_fmaxf(rm,0.f); mhat+=dl; \
        _Pragma("unroll") for(int r=0;r<16;++r){C0[r]-=dl;C1[r]-=dl;} \
        const float f=__builtin_amdgcn_exp2f(-dl); l_reg*=f; if(hi==0)wsf[r32]=f; resc=true; } } else resc=false; \
    SBAR(); \
    GAPB(o[0]=__builtin_amdgcn_mfma_f32_32x32x16_bf16(PAF(0),VFR(0),o[0],0,0,0), C0,0); \
    GAPB(o[1]=__builtin_amdgcn_mfma_f32_32x32x16_bf16(PAF(0),VFR(4),o[1],0,0,0), C0,4); \
    KRD(GL,0); GAPB(o[0]=__builtin_amdgcn_mfma_f32_32x32x16_bf16(PAF(1),VFR(1),o[0],0,0,0), C0,8); \
    KRD(GL,1); GAPB(o[1]=__builtin_amdgcn_mfma_f32_32x32x16_bf16(PAF(1),VFR(5),o[1],0,0,0), C0,12); \
    KRD(GL,2); GAPB(o[0]=__builtin_amdgcn_mfma_f32_32x32x16_bf16(PAF(2),VFR(2),o[0],0,0,0), C1,0); \
    KRD(GL,3); GAPB(o[1]=__builtin_amdgcn_mfma_f32_32x32x16_bf16(PAF(2),VFR(6),o[1],0,0,0), C1,4); \
    GAPB(o[0]=__builtin_amdgcn_mfma_f32_32x32x16_bf16(PAF(3),VFR(3),o[0],0,0,0), C1,8); \
    GAPB(o[1]=__builtin_amdgcn_mfma_f32_32x32x16_bf16(PAF(3),VFR(7),o[1],0,0,0), C1,12); \
    CINIT(P0,P1,__builtin_fmaf(s2,(float)(64*((t)+1)),-qb2)-mhat); PIN(P0); PIN(P1);     \
    }while(0)
  int t=1;
  #undef CMASK
  #define CMASK(P0,P1,t) do{}while(0)
  for(;t+5<NT;t+=2){
    STEP(pB0,pB1,pA0,pA1,t,true,true,true);     WAIT_BAR(2); RESC(); ROT();
    STEP(pA0,pA1,pB0,pB1,t+1,true,true,true);   WAIT_BAR(2); RESC(); ROT();
  }
  #undef CMASK
  #define CMASK(P0,P1,t) do{ if(WIN||(t)>=NT-4)gmask(P0,P1,64*(t),qrel,hi,WIN);}while(0)
  #define ENDW(tt) do{ if((tt)+3<NT){WAIT_BAR(2);} else if((tt)+2<NT){WAIT_BAR(1);} else {WAIT_BAR(0);} }while(0)
  for(;t+1<NT;t+=2){
    STEP(pB0,pB1,pA0,pA1,t,(t+3<NT),(t+1<NT),(t+1<NT));       ENDW(t);   RESC(); ROT();
    STEP(pA0,pA1,pB0,pB1,t+1,(t+4<NT),(t+2<NT),(t+2<NT));     ENDW(t+1); RESC(); ROT();
  }
  STEP(pB0,pB1,pA0,pA1,NT-1,false,false,false); RESC();
  if(in_>=0){ long qo,ko; unit_qk_offsets(vn,in_,qo,ko);
    const bf16*ksn=qkvb+ko+(long)lane*PIN+wid*8;
    glds16(ksn,(unsigned)__builtin_amdgcn_readfirstlane(kdst)); glds16(ksn+(long)KVBLK*PIN,(unsigned)__builtin_amdgcn_readfirstlane(kdst+SLOTB)); glds16(ksn+(long)2*KVBLK*PIN,(unsigned)__builtin_amdgcn_readfirstlane(kdst+2*SLOTB));
    const bf16*Qwn=qkvb+qo+(long)(wid*QBLK)*PIN;
    _Pragma("unroll") for(int d0=0;d0<4;++d0)qr[d0]=*reinterpret_cast<const bf16x8*>(&Qwn[(long)r32*PIN+d0*16+hi*8]); }
  { float sacc=pB0[0]+pB0[1]; _Pragma("unroll") for(int r=2;r<16;++r)sacc+=pB0[r]; _Pragma("unroll") for(int r=0;r<16;++r)sacc+=pB1[r]; l_reg+=sacc;
    pw0=(u32x4){PKW(pB0,0),PKW(pB0,2),PKW(pB0,4),PKW(pB0,6)};pw1=(u32x4){PKW(pB0,8),PKW(pB0,10),PKW(pB0,12),PKW(pB0,14)};pw2=(u32x4){PKW(pB1,0),PKW(pB1,2),PKW(pB1,4),PKW(pB1,6)};pw3=(u32x4){PKW(pB1,8),PKW(pB1,10),PKW(pB1,12),PKW(pB1,14)};
    SBAR(); pv(o,vb0+sl_cur,PAF(0),PAF(1),PAF(2),PAF(3)); }
  #undef PKW
  #undef PAF
  #undef VFR
  #undef PIN
  #undef MX3
  #undef GAPA
  #undef GAPB
  #undef EX
  #undef VRD
  #undef KRD
  #undef STEP
  #undef ENDW
  {auto rr=__builtin_amdgcn_permlane32_swap(__float_as_uint(l_reg),__float_as_uint(l_reg),false,false);l_reg=__uint_as_float(rr[0])+__uint_as_float(rr[1]);}
  l_reg+=__builtin_amdgcn_exp2f(sink2-mhat);
  if(hi==0)wsf[32+r32]=l_reg;asm volatile("s_waitcnt lgkmcnt(0)":::"memory");
  float rli[16];
  #pragma unroll
  for(int r=0;r<16;++r)rli[r]=__builtin_amdgcn_rcpf(wsf[32+crow(r,hi)]);
  bf16*Ow=Oc+(rowbase+q0+wid*QBLK)*POUT;
  { bf16*stg=(bf16*)(shm+LDS_OST)+wid*2048;
    #pragma unroll
    for(int r=0;r<16;++r){const int orow=crow(r,hi);
      #pragma unroll
      for(int d0=0;d0<2;++d0)stg[orow*64+d0*32+r32]=__float2bfloat16(o[d0][r]*rli[r]);}
    asm volatile("s_waitcnt lgkmcnt(0)":::"memory");
    #pragma unroll
    for(int i=0;i<4;++i){const int row=i*8+(lane>>3),ch=lane&7; const u32x4 v=*(const u32x4*)(stg+row*64+ch*8); ATTN_STORE16(Ow+(long)row*POUT+ch*8,v);} }
  asm volatile("s_waitcnt lgkmcnt(0)\n\ts_barrier":::"memory");
  #undef DMA_K
  #undef DMA_V
  #undef CMASK
  #undef START
  #undef RESC
  #undef ROT
  #undef CINIT
}
constexpr int ATTN_LDS_BYTES=LDS_BYTES;
#undef SBAR
#undef WAIT_BAR
}
constexpr int NWAVES = 8;
constexpr int BATCH = 4, SEQ = 8192, DM = 1024, DEPTH = 4, M = BATCH * SEQ;
constexpr int INC = 4352, FFH = 2816, NQKV = 2304, NGATE = 2048;
constexpr size_t MiB = 1u << 20;
constexpr size_t WS_WIN = 0, WS_WB = 9 * MiB, WS_WO = 11 * MiB, WS_W1 = 13 * MiB, WS_W2 = 24 * MiB;
constexpr size_t WS_PSS = 30 * MiB;
constexpr size_t WS_QKV = 32 * MiB;
constexpr size_t WS_GATE = 176 * MiB;
constexpr size_t WS_ACT = 32 * MiB;
constexpr size_t WS_OA = 304 * MiB, WS_OB = 336 * MiB;
constexpr size_t WS_XB = 434 * MiB;
constexpr size_t WS_OD0 = 368 * MiB, WS_OD1 = 400 * MiB;
constexpr size_t WS_MRG = 368 * MiB;
constexpr size_t WS_END = 432 * MiB;
static_assert((DEPTH & 1) == 0 && WS_WIN + (size_t)INC * DM * 2 <= WS_WB && WS_W1 + (size_t)2 * FFH * DM * 2 <= WS_W2 && WS_W2 + (size_t)DM * FFH * 2 <= WS_PSS && WS_QKV + (size_t)M * NQKV * 2 <= WS_GATE && WS_GATE + (size_t)M * NGATE * 2 <= WS_OA && WS_ACT + (size_t)M * FFH * 2 <= WS_OA, "ws map");
constexpr int RING_BYTES = 131072, LDS_BYTES = 147456;
#define GAS __attribute__((address_space(1)))
#define LAS __attribute__((address_space(3)))
typedef unsigned short bf16;
typedef unsigned v4u __attribute__((ext_vector_type(4)));
typedef float f32x4 __attribute__((ext_vector_type(4)));
#define LDS_WAIT() asm volatile("s_waitcnt lgkmcnt(0)" ::: "memory")
__device__ __forceinline__ unsigned f2bf(float f) { unsigned u = __builtin_bit_cast(unsigned, f); return (u + 0x7fffu + ((u >> 16) & 1u)) >> 16; }
__device__ __forceinline__ unsigned pk2(float lo, float hi) { return f2bf(lo) | (f2bf(hi) << 16); }
__device__ __forceinline__ float wave_sum(float v) {
#pragma unroll
    for (int o = 1; o < 64; o <<= 1) v += __shfl_xor(v, o);
    return v;
}
__device__ __forceinline__ void transpose_item(const float* W, int ldw, const float* gain, bf16* WT, int K, int dst_row0, int k0, int n0, LAS float* scr, int lane) {
    float v[32];
#pragma unroll
    for (int i = 0; i < 32; ++i) { const int kk = 2 * i + (lane >> 5); v[i] = W[(size_t)(k0 + kk) * ldw + n0 + (lane & 31)]; }
    if (gain) {
#pragma unroll
        for (int i = 0; i < 32; ++i) v[i] *= gain[k0 + 2 * i + (lane >> 5)]; }
#pragma unroll
    for (int i = 0; i < 32; ++i) scr[(2 * i + (lane >> 5)) * 33 + (lane & 31)] = v[i];
    LDS_WAIT(); asm volatile("" ::: "memory");
    const int c = lane & 7;
#pragma unroll
    for (int j = 0; j < 4; ++j) { const int n = (lane >> 3) + 8 * j; const LAS float* s = scr + (8 * c) * 33 + n;
        v4u o; o.x = pk2(s[0 * 33], s[1 * 33]); o.y = pk2(s[2 * 33], s[3 * 33]); o.z = pk2(s[4 * 33], s[5 * 33]); o.w = pk2(s[6 * 33], s[7 * 33]);
        *(GAS v4u*)(WT + (size_t)(dst_row0 + n) * K + k0 + 8 * c) = o; }
    LDS_WAIT(); asm volatile("" ::: "memory");
}
#define RLX_AGENT __ATOMIC_RELAXED, __HIP_MEMORY_SCOPE_AGENT
#define XB_TMO      128
#define XB_XCNT(j)  (256  + 64 * (j))
#define XB_XSUB(j)  (1280 + 64 * (j))
#define XB_XGEN(j)  (2304 + 64 * (j))
#define XB_TOP      3328
#define XB_TOPGEN   3392
#define XCD_BAR_WORDS 3456
#define XB_SPIN_CAP (1u << 18)

__device__ __forceinline__ unsigned xb_ld(unsigned* p)              { return __hip_atomic_load(p, __ATOMIC_RELAXED, __HIP_MEMORY_SCOPE_AGENT); }
__device__ __forceinline__ unsigned xb_add(unsigned* p, unsigned v) { return __hip_atomic_fetch_add(p, v, __ATOMIC_RELAXED, __HIP_MEMORY_SCOPE_AGENT); }
__device__ __forceinline__ unsigned xb_xcc_id() { return (unsigned)__builtin_amdgcn_s_getreg((3 << 11) | 20) & 0xFu; }
#define XB_SPIN(cond, bar) do { unsigned _sp = 0; while (cond) { __builtin_amdgcn_s_sleep(1); \
    if ((++_sp & 255u) == 0u) { if (xb_ld(&(bar)[XB_TMO])) break; if (_sp > XB_SPIN_CAP) { atomicAdd(&(bar)[XB_TMO], 1u); break; } } } } while (0)

struct XcdBarrier {
    unsigned* bar; unsigned x;
    volatile LAS unsigned* st;
};

__device__ __forceinline__ XcdBarrier xcd_barrier_post(unsigned* bar, volatile LAS unsigned* st) {
    XcdBarrier b; b.bar = bar; b.x = xb_xcc_id(); b.st = st;
    if (threadIdx.x == 0) (void)xb_add(&bar[XB_XCNT(b.x)], 1u);
    return b;
}
__device__ __forceinline__ void xcd_barrier_complete(unsigned* bar, unsigned x, unsigned& nloc, unsigned& nx) {
    const unsigned G = gridDim.x * gridDim.y * gridDim.z;
    unsigned sum, cnt, mine, sp = 0u;
    for (;;) {
        sum = 0u; cnt = 0u; mine = 0u;
#pragma unroll
        for (unsigned j = 0; j < 16; ++j) { const unsigned c = xb_ld(&bar[XB_XCNT(j)]); sum += c; cnt += (c > 0u) ? 1u : 0u; mine = (j == x) ? c : mine; }
        if (sum == G) break;
        __builtin_amdgcn_s_sleep(1);
        if ((++sp & 255u) == 0u) { if (xb_ld(&bar[XB_TMO])) break; if (sp > XB_SPIN_CAP) { atomicAdd(&bar[XB_TMO], 1u); break; } }
    }
    nloc = mine > 0u ? mine : 1u; nx = cnt > 0u ? cnt : 1u;
}

__device__ __forceinline__ void xcd_barrier(const XcdBarrier& b) {
    asm volatile("s_waitcnt vmcnt(0)" ::: "memory");
    __syncthreads();
    if (threadIdx.x == 0) {
        unsigned* bar = b.bar;
        __builtin_amdgcn_s_waitcnt(0);
        unsigned nloc = b.st[0], nx = b.st[1];
        if (nloc == 0u) { xcd_barrier_complete(bar, b.x, nloc, nx); b.st[0] = nloc; b.st[1] = nx; }
        const unsigned old = xb_add(&bar[XB_XSUB(b.x)], 1u);
        const unsigned gen = old / nloc;
        if (old + 1u == (gen + 1u) * nloc) {
            __builtin_amdgcn_fence(__ATOMIC_RELEASE, "agent");
            asm volatile("s_waitcnt vmcnt(0)" ::: "memory");
            const unsigned og = xb_add(&bar[XB_TOP], 1u);
            const unsigned tg = og / nx;
            if (og + 1u == (tg + 1u) * nx) xb_add(&bar[XB_TOPGEN], 1u);
            else XB_SPIN(xb_ld(&bar[XB_TOPGEN]) == tg, bar);
            __builtin_amdgcn_fence(__ATOMIC_ACQUIRE, "agent");
            xb_add(&bar[XB_XGEN(b.x)], 1u);
            asm volatile("s_waitcnt vmcnt(0)" ::: "memory");
        } else {
            XB_SPIN(xb_ld(&bar[XB_XGEN(b.x)]) == gen, bar);
            __builtin_amdgcn_fence(__ATOMIC_ACQUIRE, "agent");
            asm volatile("s_waitcnt vmcnt(0)" ::: "memory");
        }
    }
    __syncthreads();
}

constexpr size_t WS_CTL = WS_END, CTL_ZERO_BYTES = 65536;
constexpr int CW_BAR = 1024;
constexpr int MISC_OFF = RING_BYTES + 320;
struct Args { const float* in[14]; float* out; unsigned char* ws; };

typedef const __attribute__((address_space(4))) Args* kargs_t;
#define WBASE(l) (((l) & 1) ? ap->ws : (unsigned char*)ap->out)
#define WB(l, off) ((bf16*)(WBASE(l) + (off)))
__device__ __forceinline__ void convert_weights(kargs_t ap, int lw, LAS float* scr, int lane, int it0, int stride) {
    const int l = lw; unsigned char* wb = WBASE(lw);
    bf16* WINt = (bf16*)(wb + WS_WIN); bf16* WBt = (bf16*)(wb + WS_WB); bf16* WOt = (bf16*)(wb + WS_WO); bf16* W1t = (bf16*)(wb + WS_W1); bf16* W2t = (bf16*)(wb + WS_W2);
    const float* w_in = ap->in[1] + (size_t)l * DM * INC; const float* w_br = ap->in[3] + (size_t)l * 2 * 512 * DM; const float* w_o = ap->in[4] + (size_t)l * DM * DM;
    const float* w_1 = ap->in[12] + (size_t)l * DM * 2 * FFH; const float* w_2 = ap->in[13] + (size_t)l * FFH * DM;
    const float* g_mix = ap->in[5] + l * DM; const float* g_ffn = ap->in[6] + l * DM;
            constexpr int I_IN = (DM / 64) * (INC / 32), I_BR = (512 / 64) * (DM / 32), I_O = (DM / 64) * (DM / 32), I_1 = (DM / 64) * (2 * FFH / 32), I_2 = (FFH / 64) * (DM / 32);
    constexpr int NITEMS = I_IN + 2 * I_BR + I_O + I_1 + I_2;
    for (int it = it0; it < NITEMS; it += stride) {
        int r = it;
        if (r < I_IN) { const int nblk = INC / 32, kb = r / nblk, nb = r % nblk, n0 = 32 * nb; int dst = n0;
            if (n0 < 2304) { const int pn = n0 >> 8, lb = (n0 & 255) >> 5; dst = 256 * pn + 128 * (lb & 1) + 32 * (lb >> 1); }
            transpose_item(w_in, INC, g_mix, WINt, DM, dst, 64 * kb, n0, scr, lane); continue; } r -= I_IN;
        if (r < 2 * I_BR) { const int z = r / I_BR; r -= z * I_BR; const int nblk = DM / 32, kb = r / nblk, nb = r % nblk;
            transpose_item(w_br + (size_t)z * 512 * DM, DM, nullptr, WBt + (size_t)z * DM * 512, 512, 32 * nb, 64 * kb, 32 * nb, scr, lane); continue; } r -= 2 * I_BR;
        if (r < I_O) { const int nblk = DM / 32, kb = r / nblk, nb = r % nblk; transpose_item(w_o, DM, nullptr, WOt, DM, 32 * nb, 64 * kb, 32 * nb, scr, lane); continue; } r -= I_O;
        if (r < I_1) { const int nblk = 2 * FFH / 32, kb = r / nblk, nb = r % nblk, n0 = 32 * nb; int dst;
            if (n0 < FFH) dst = 256 * (n0 >> 7) + (n0 & 127); else { const int n1 = n0 - FFH; dst = 256 * (n1 >> 7) + 128 + (n1 & 127); }
            transpose_item(w_1, 2 * FFH, g_ffn, W1t, DM, dst, 64 * kb, n0, scr, lane); continue; } r -= I_1;
        { const int nblk = DM / 32, kb = r / nblk, nb = r % nblk; transpose_item(w_2, DM, nullptr, W2t, FFH, 32 * nb, 64 * kb, 32 * nb, scr, lane); }
    }
}

__global__ void __launch_bounds__(NWAVES * 64, 2) mk_fwd(Args args) {
    extern __shared__ __attribute__((aligned(16))) unsigned char lds[];
    cg::grid_group grid = cg::this_grid();
    LAS unsigned char* ldsp = (LAS unsigned char*)lds;
    for (int u = threadIdx.x; u < (LDS_BYTES - RING_BYTES) / 4; u += NWAVES * 64) ((LAS unsigned*)(ldsp + RING_BYTES))[u] = 0u;
    __syncthreads();
    const XcdBarrier bar = xcd_barrier_post((unsigned*)(args.ws + WS_CTL) + CW_BAR, (volatile LAS unsigned*)(ldsp + MISC_OFF) + 8);
    grid.sync();
    const int G = gridDim.x; const int bx = blockIdx.x; const int vcu = (G % 8 == 0) ? (bx % 8) * (G / 8) + bx / 8 : bx;
    const int NGW = G * NWAVES;
#define LANE_WAVE() int tid_ = threadIdx.x; asm volatile("" : "+v"(tid_)); const int lane = tid_ & 63, wave = __builtin_amdgcn_readfirstlane(tid_ >> 6), gw = vcu * NWAVES + wave;
#define KARGS() ({ kargs_t p_ = (kargs_t)__builtin_amdgcn_kernarg_segment_ptr(); asm volatile("" : "+s"(p_)); p_; })
#define WSP(T, off) ((T*)(ap->ws + (off)))
#define GRID_SYNC() xcd_barrier(bar)
#pragma clang loop unroll(disable)
    for (int l = 0; l < DEPTH; ++l) {
        if (l == 0) {
            LANE_WAVE();
            kargs_t ap = KARGS();
            convert_weights(ap, 0, (LAS float*)(ldsp + wave * 16384), lane, gw, NGW);
            {   bf16* XB = WSP(bf16, WS_XB); float* PSS = WSP(float, WS_PSS);
                for (int m0 = gw; m0 < M; m0 += 4 * NGW) {
                    f32x4 v[4][4];
#pragma unroll
                    for (int q = 0; q < 4; ++q) { const int m = m0 + q * NGW; const GAS f32x4* xr = (const GAS f32x4*)(ap->in[0] + (size_t)(m < M ? m : 0) * DM) + lane;
#pragma unroll
                        for (int j = 0; j < 4; ++j) v[q][j] = xr[64 * j]; }
#pragma unroll
                    for (int q = 0; q < 4; ++q) { const int m = m0 + q * NGW; float s = 0.f;
#pragma unroll
                        for (int j = 0; j < 4; ++j) s += (v[q][j].x * v[q][j].x + v[q][j].y * v[q][j].y) + (v[q][j].z * v[q][j].z + v[q][j].w * v[q][j].w);
                        s = wave_sum(s);
                        if (m < M) { GAS unsigned long long* o8 = (GAS unsigned long long*)(XB + (size_t)m * DM) + lane;
#pragma unroll
                            for (int j = 0; j < 4; ++j) o8[64 * j] = (unsigned long long)pk2(v[q][j].x, v[q][j].y) | ((unsigned long long)pk2(v[q][j].z, v[q][j].w) << 32);
                            if (lane < 4) PSS[(size_t)lane * M + m] = (lane == 0) ? s : 0.f; } }
                }
            }
            GRID_SYNC();
        }
        {
            kargs_t ap = KARGS();
            pg8::Gemm g{WSP(bf16, WS_XB), WB(l, WS_WIN), M, INC, DM, 0, 0}; pg8::StaticOrder S; S.init(M, INC, G, bx);
            pg8::EpiInProj E{WSP(bf16, WS_QKV), WSP(bf16, WS_GATE), WSP(float, WS_PSS), ap->in[7] + l * 128, ap->in[8] + l * 128, ap->in[2] + l * 2048};
            pg8::gemm_phase<pg8::EpiInProj, pg8::StaticOrder, true, true>(ldsp, g, S, E);
            if (l + 1 < DEPTH) {
                const int nun = (M / 256) * (INC / 256), first_idle = nun - (nun / G) * G; int ncv = G, icv = bx;
                if (first_idle > 0 && first_idle < G) { ncv = G - first_idle; icv = bx - first_idle; }
                if (icv >= 0) { LANE_WAVE(); (void)gw; convert_weights(KARGS(), l + 1, (LAS float*)(ldsp + wave * 16384), lane, icv * NWAVES + wave, ncv * NWAVES); }
            }
        }
        GRID_SYNC();
        {
            kargs_t ap = KARGS(); bf16* QKV = WSP(bf16, WS_QKV); bf16* OA = WSP(bf16, WS_OA); bf16* OD0 = WSP(bf16, WS_OD0); bf16* OD1 = WSP(bf16, WS_OD1);
            const float LOG2E = 1.4426950408889634f;
            bool nomax_swa, nomax_diff;
            { LANE_WAVE(); (void)gw; (void)wave;
              float a0 = fabsf(ap->in[7][l * 128 + lane]), a1 = fabsf(ap->in[7][l * 128 + 64 + lane]), d0 = fabsf(ap->in[8][l * 128 + lane]), d1 = fabsf(ap->in[8][l * 128 + 64 + lane]);
#pragma unroll
              for (int o = 1; o < 64; o <<= 1) { a0 = fmaxf(a0, __shfl_xor(a0, o)); a1 = fmaxf(a1, __shfl_xor(a1, o)); d0 = fmaxf(d0, __shfl_xor(d0, o)); d1 = fmaxf(d1, __shfl_xor(d1, o)); }
              nomax_swa = (8.0f * LOG2E * 1.02f * a0 * a1) <= 40.0f; nomax_diff = (8.0f * LOG2E * 1.02f * d0 * d1) <= 40.0f; }
            attn_body::bf16x8 qfr[4]; bool pref = false;
            for (int v = vcu; v < 256; v += G) {
                for (int i = 0; i < 12; ++i) {
                    long rowbase; int qb, t0, qc, kc, vc, oc; bool win; float s2, sink2; bf16* Ob;
                    if (i < 8) {
                        const int s = v & 7, bhv = (v >> 3) + 32 * (i >> 2), ii = i & 3, b = bhv >> 4, h = (bhv >> 2) & 3, c = (bhv >> 1) & 1, vh = bhv & 1;
                        qb = (ii == 0) ? s : (ii == 1) ? 15 - s : (ii == 2) ? 16 + s : 31 - s; t0 = 0; win = false; rowbase = (long)b * SEQ;
                        qc = 768 + h * 128 + c * 64; kc = 1280 + h * 128 + c * 64; vc = 1792 + h * 128 + vh * 64; oc = h * 128 + vh * 64; Ob = c ? OD1 : OD0;
                        s2 = exp2f(-8.0f * (float)(9 + h) / 12.0f) * LOG2E; sink2 = -INFINITY;
                    } else {
                        const int ui = v * 4 + (i - 8), hq = (ui >> 5) & 7, b = ui >> 8; qb = ui & 31; t0 = qb > 0 ? 4 * qb - 2 : 0; win = true; rowbase = (long)b * SEQ;
                        qc = hq * 64; kc = 512 + (hq >> 2) * 64; vc = 640 + (hq >> 2) * 64; oc = hq * 64; Ob = OA;
                        s2 = exp2f(-8.0f * (float)(1 + hq) / 12.0f) * LOG2E; sink2 = ap->in[9][l * 8 + hq] * LOG2E;
                    }
                    int vn = v, in = i + 1; if (in == 12) { in = 0; vn = v + G; }
                    if (vn >= 256) in = -1;
                    attn_body::attn_unit<60>(rowbase, qb, t0, win, win ? nomax_swa : nomax_diff, (const attn_body::bf16*)QKV + qc, (const attn_body::bf16*)QKV + kc, (const attn_body::bf16*)QKV + vc, (attn_body::bf16*)Ob + oc, s2, sink2, (char*)lds,
                        qfr, pref, (const attn_body::bf16*)QKV, vn, in);
                    pref = in >= 0;
                }
            }
        }
        GRID_SYNC();
        {
            LANE_WAVE();
            kargs_t ap = KARGS(); bf16* OD0 = WSP(bf16, WS_OD0); bf16* OD1 = WSP(bf16, WS_OD1); bf16* OB = WSP(bf16, WS_OB);
            const float lam_init = 0.8f - 0.6f * expf(-0.3f * (float)l);
            const float* lp = ap->in[10] + l * 256;
            const float lam = expf(wave_sum(lp[lane] * lp[64 + lane])) - expf(wave_sum(lp[128 + lane] * lp[192 + lane])) + lam_init;
            const float* sl = ap->in[11] + l * 128 + (8 * lane & 127);
            float gsc[8];
#pragma unroll
            for (int i = 0; i < 8; ++i) gsc[i] = sl[i] * (1.0f - lam_init);
            for (int m0 = gw; m0 < M; m0 += 4 * NGW) {
                v4u a[4], b[4];
#pragma unroll
                for (int j = 0; j < 4; ++j) { const int m = m0 + j * NGW; if (m < M) { a[j] = *(const GAS v4u*)(OD0 + (size_t)m * 512 + 8 * lane); b[j] = *(const GAS v4u*)(OD1 + (size_t)m * 512 + 8 * lane); } else { a[j] = (v4u){0u, 0u, 0u, 0u}; b[j] = a[j]; } }
#pragma unroll
                for (int j = 0; j < 4; ++j) { const int m = m0 + j * NGW;
                    float o[8];
#pragma unroll
                    for (int i = 0; i < 4; ++i) { o[2 * i] = __uint_as_float(a[j][i] << 16) - lam * __uint_as_float(b[j][i] << 16); o[2 * i + 1] = __uint_as_float(a[j][i] & 0xffff0000u) - lam * __uint_as_float(b[j][i] & 0xffff0000u); }
                    float ss = 0.f;
#pragma unroll
                    for (int i = 0; i < 8; ++i) ss += o[i] * o[i];
                    ss += __shfl_xor(ss, 1); ss += __shfl_xor(ss, 2); ss += __shfl_xor(ss, 4); ss += __shfl_xor(ss, 8);
                    const float rn = __builtin_amdgcn_rsqf(ss * (1.0f / 128.0f) + 1e-6f);
                    v4u w;
#pragma unroll
                    for (int i = 0; i < 4; ++i) w[i] = pk2(o[2 * i] * rn * gsc[2 * i], o[2 * i + 1] * rn * gsc[2 * i + 1]);
                    if (m < M) *(GAS v4u*)(OB + (size_t)m * 512 + 8 * lane) = w; }
            }
        }
        GRID_SYNC();
        {
            kargs_t ap = KARGS();
            pg8::Gemm g{WSP(bf16, WS_OA), WB(l, WS_WB), M, DM, 512, (size_t)(WS_OB - WS_OA), (size_t)DM * 512 * 2}; pg8::ZOrder S; S.S.init(M, DM, G, bx);
            pg8::EpiGateMerge E{WSP(bf16, WS_GATE), WSP(bf16, WS_MRG)};
            pg8::gemm_phase<pg8::EpiGateMerge, pg8::ZOrder, true, true>(ldsp, g, S, E);
        }
        GRID_SYNC();
        {
            kargs_t ap = KARGS(); float* out = ap->out;
            pg8::Gemm g{WSP(bf16, WS_MRG), WB(l, WS_WO), M, DM, DM, 0, 0}; pg8::StaticOrder S; S.init(M, DM, G, bx);
            pg8::EpiResid E{nullptr, WSP(bf16, WS_XB), WSP(float, WS_PSS), (LAS float*)(ldsp + RING_BYTES + 1024)}; (void)out;
            pg8::gemm_phase<pg8::EpiResid, pg8::StaticOrder, true, true>(ldsp, g, S, E);
        }
        GRID_SYNC();
        {
            kargs_t ap = KARGS();
            pg8::Gemm g{WSP(bf16, WS_XB), WB(l, WS_W1), M, 2 * FFH, DM, 0, 0}; pg8::StaticOrder S; S.init(M, 2 * FFH, G, bx);
            pg8::EpiSwiGLU E{WSP(bf16, WS_ACT), WSP(float, WS_PSS)};
            pg8::gemm_phase<pg8::EpiSwiGLU, pg8::StaticOrder, true, true>(ldsp, g, S, E);
        }
        GRID_SYNC();
        {
            kargs_t ap = KARGS(); float* out = ap->out;
            pg8::Gemm g{WSP(bf16, WS_ACT), WB(l, WS_W2), M, DM, FFH, 0, 0}; pg8::StaticOrder S; S.init(M, DM, G, bx);
            pg8::EpiResid E{l == DEPTH - 1 ? out : nullptr, WSP(bf16, WS_XB), WSP(float, WS_PSS), (LAS float*)(ldsp + RING_BYTES + 1024)};
            pg8::gemm_phase<pg8::EpiResid, pg8::StaticOrder, true, true>(ldsp, g, S, E);
        }
        GRID_SYNC();
    }
}

extern "C" void kernel_launch(void* const* d_in, const int* in_sizes, int n_in, void* d_out, int out_size, void* d_ws, size_t ws_size, hipStream_t stream) {
    static int grid = 0;
    if (grid == 0) {
        if (n_in != 14 || in_sizes[0] != M * DM || out_size != M * DM || ws_size < WS_XB + 64 * MiB) { fprintf(stderr, "kernel_launch: unexpected shapes (n_in %d, in0 %d, out %d, ws %zu); nothing launched\n", n_in, n_in > 0 ? in_sizes[0] : -1, out_size, ws_size); grid = -1; return; }
        int dev = 0, cus = 0, per_cu = 0;
        if (hipGetDevice(&dev) != hipSuccess || hipDeviceGetAttribute(&cus, hipDeviceAttributeMultiprocessorCount, dev) != hipSuccess) { grid = -1; return; }
        if (hipFuncSetAttribute((const void*)mk_fwd, hipFuncAttributeMaxDynamicSharedMemorySize, LDS_BYTES) != hipSuccess) { fprintf(stderr, "kernel_launch: hipFuncSetAttribute failed\n"); grid = -1; return; }
        if (hipOccupancyMaxActiveBlocksPerMultiprocessor(&per_cu, (const void*)mk_fwd, NWAVES * 64, LDS_BYTES) != hipSuccess || per_cu < 1) { fprintf(stderr, "kernel_launch: occupancy query says %d\n", per_cu); per_cu = 1; }
        (void)hipGetLastError();
        grid = cus * per_cu;
    }
    if (grid < 0) return;
    if (hipMemsetAsync((char*)d_ws + WS_CTL, 0, CTL_ZERO_BYTES, stream) != hipSuccess) { fprintf(stderr, "kernel_launch: hipMemsetAsync failed\n"); return; }
    Args a{};
    for (int i = 0; i < 14; ++i) a.in[i] = (const float*)d_in[i];
    a.out = (float*)d_out; a.ws = (unsigned char*)d_ws;
    void* kargs[] = {&a};
    hipError_t e = hipLaunchCooperativeKernel((const void*)mk_fwd, dim3(grid), dim3(NWAVES * 64), kargs, LDS_BYTES, stream);
    if (e != hipSuccess) fprintf(stderr, "cooperative launch failed: %s (grid %d)\n", hipGetErrorString(e), grid);
}
```
